# Optimizing an MI355X kernel written in HIP

```python
import jax, jax.numpy as jnp
from jax import lax
import numpy as np

D_MODEL = 1024
BATCH = 16
SEQ = 4096
DEPTH = 1

MEM_LEN = 256
CHUNK = 64
EPS = 1e-6
MLSTM_HEADS = 4
MLSTM_W = D_MODEL // 2
MLSTM_HD = MLSTM_W // MLSTM_HEADS
CONV_W = 4
F_BIAS_LO = 3.0
F_BIAS_HI = 6.0
GLA_HEADS = 4
GLA_WV = D_MODEL // 2
GLA_WK = GLA_WV // 2
GLA_DK = GLA_WK // GLA_HEADS
GLA_DV = GLA_WV // GLA_HEADS
GLA_RANK = 16
GLA_TAU = 16.0
XATTN_HEADS = 4
XATTN_HD = D_MODEL // XATTN_HEADS
D_FF = 4 * D_MODEL

IN_SPLITS = [MLSTM_W, MLSTM_W, MLSTM_W, MLSTM_W, MLSTM_HEADS, MLSTM_HEADS,
             GLA_WK, GLA_WK, GLA_WV, GLA_WV, GLA_RANK]
D_IN = sum(IN_SPLITS)
IN_SPLIT_IDX = [int(c) for c in np.cumsum(IN_SPLITS)[:-1]]
MIX_W = MLSTM_W + GLA_WV

kernel_name = 'hybrid_mlstm_gla_block'


def rmsnorm(x, g):
    xf = x.astype(jnp.float32)
    y = xf * lax.rsqrt(jnp.mean(xf * xf, axis=-1, keepdims=True) + EPS)
    return y.astype(x.dtype) * g


def head_rmsnorm(h, g):
    y = h * lax.rsqrt(jnp.mean(h * h, axis=-1, keepdims=True) + EPS)
    B, S = y.shape[:2]
    return y.reshape(B, S, -1) * g.astype(jnp.float32)


def causal_conv(x, w, b):
    S = x.shape[1]
    xp = jnp.pad(x, ((0, 0), (CONV_W - 1, 0), (0, 0)))
    y = xp[:, 0:S] * w[0]
    for j in range(1, CONV_W):
        y = y + xp[:, j:j + S] * w[j]
    return y + b


def to_chunks(t, n_heads):
    B, S = t.shape[:2]
    return t.reshape(B, S // CHUNK, CHUNK, n_heads, -1).transpose(1, 0, 3, 2, 4)


def gate_chunks(t):
    B, S, H = t.shape
    return t.reshape(B, S // CHUNK, CHUNK, H).transpose(1, 0, 3, 2)


def from_chunks(t):
    NC, B, H, L, d = t.shape
    return t.transpose(1, 0, 3, 2, 4).reshape(B, NC * L, H, d)


def mlstm_chunkwise(q, k, v, log_i, log_f):
    NC, B, H, L, d = q.shape
    causal = jnp.tril(jnp.ones((L, L), dtype=bool))

    def step(carry, inp):
        C, n, m = carry
        qc, kc, vc, li, lf = inp
        b = jnp.cumsum(lf, axis=-1)
        D = jnp.where(causal, b[..., :, None] - b[..., None, :] + li[..., None, :], -jnp.inf)
        inter = b + m[..., None]
        m_t = jnp.maximum(jnp.max(D, axis=-1), inter)
        s = jnp.einsum('bhtd,bhsd->bhts', qc, kc) * jnp.exp(D - m_t[..., None])
        w_inter = jnp.exp(inter - m_t)
        num = (jnp.einsum('bhts,bhse->bhte', s, vc)
               + w_inter[..., None] * jnp.einsum('bhtd,bhde->bhte', qc, C))
        den = jnp.sum(s, axis=-1) + w_inter * jnp.einsum('bhtd,bhd->bht', qc, n)
        h = num / jnp.maximum(jnp.abs(den), jnp.exp(-m_t))[..., None]
        bL = b[..., -1]
        g = bL[..., None] - b + li
        m_new = jnp.maximum(bL + m, jnp.max(g, axis=-1))
        decay = jnp.exp(bL + m - m_new)
        wk = jnp.exp(g - m_new[..., None])[..., None] * kc
        C_new = decay[..., None, None] * C + jnp.einsum('bhsd,bhse->bhde', wk, vc)
        n_new = decay[..., None] * n + jnp.sum(wk, axis=2)
        return (C_new, n_new, m_new), h

    init = (jnp.zeros((B, H, d, v.shape[-1]), jnp.float32),
            jnp.zeros((B, H, d), jnp.float32),
            jnp.zeros((B, H), jnp.float32))
    _, h = lax.scan(step, init, (q, k, v, log_i, log_f))
    return h


def gla_chunkwise(q, k, v, log_a):
    NC, B, H, L, dk = q.shape
    causal = jnp.tril(jnp.ones((L, L), dtype=bool))

    def step(Sst, inp):
        qc, kc, vc, la = inp
        b = jnp.cumsum(la, axis=2)
        diff = jnp.where(causal[:, :, None], b[:, :, :, None, :] - b[:, :, None, :, :], -jnp.inf)
        A = jnp.einsum('bhtd,bhsd,bhtsd->bhts', qc, kc, jnp.exp(diff))
        o = (jnp.einsum('bhts,bhse->bhte', A, vc)
             + jnp.einsum('bhtd,bhde->bhte', qc * jnp.exp(b), Sst))
        bL = b[:, :, -1]
        kw = kc * jnp.exp(bL[:, :, None] - b)
        S_new = jnp.exp(bL)[..., None] * Sst + jnp.einsum('bhsd,bhse->bhde', kw, vc)
        return S_new, o

    init = jnp.zeros((B, H, dk, v.shape[-1]), jnp.float32)
    _, o = lax.scan(step, init, (q, k, v, log_a))
    return o


def setup_inputs(seed: int = 0) -> dict:
    key = jax.random.key(seed)
    ks = jax.random.split(key, 24)
    f32 = jnp.float32

    def nrm(k, shape, scale):
        return jax.random.normal(k, shape, f32) * scale

    def gain(k, shape):
        return 1.0 + 0.01 * jax.random.normal(k, shape, f32)

    f_bias = (jnp.linspace(F_BIAS_LO, F_BIAS_HI, MLSTM_HEADS, dtype=f32)[None]
              + nrm(ks[6], (DEPTH, MLSTM_HEADS), 0.01))
    return {
        'x': nrm(ks[0], (BATCH, SEQ, D_MODEL), 1.0),
        'mem': nrm(ks[1], (BATCH, MEM_LEN, D_MODEL), 1.0),
        'mix_norm_g': gain(ks[2], (DEPTH, D_MODEL)),
        'w_in': nrm(ks[3], (DEPTH, D_MODEL, D_IN), D_MODEL ** -0.5),
        'conv_w': nrm(ks[4], (DEPTH, CONV_W, 2 * MLSTM_W), CONV_W ** -0.5),
        'conv_b': nrm(ks[5], (DEPTH, 2 * MLSTM_W), 0.01),
        'mlstm_i_b': nrm(ks[7], (DEPTH, MLSTM_HEADS), 0.1),
        'mlstm_f_b': f_bias,
        'mlstm_norm_g': gain(ks[8], (DEPTH, MLSTM_W)),
        'gla_wa2': nrm(ks[9], (DEPTH, GLA_RANK, GLA_WK), GLA_RANK ** -0.5),
        'gla_ba': nrm(ks[10], (DEPTH, GLA_WK), 0.1),
        'gla_norm_g': gain(ks[11], (DEPTH, GLA_WV)),
        'w_out': nrm(ks[12], (DEPTH, MIX_W, D_MODEL), MIX_W ** -0.5),
        'xattn_norm_g': gain(ks[13], (DEPTH, D_MODEL)),
        'mem_norm_g': gain(ks[14], (DEPTH, D_MODEL)),
        'wq_x': nrm(ks[15], (DEPTH, D_MODEL, D_MODEL), D_MODEL ** -0.5),
        'wk_x': nrm(ks[16], (DEPTH, D_MODEL, D_MODEL), D_MODEL ** -0.5),
        'wv_x': nrm(ks[17], (DEPTH, D_MODEL, D_MODEL), D_MODEL ** -0.5),
        'wo_x': nrm(ks[18], (DEPTH, D_MODEL, D_MODEL), D_MODEL ** -0.5),
        'mlp_norm_g': gain(ks[19], (DEPTH, D_MODEL)),
        'w1': nrm(ks[20], (DEPTH, D_MODEL, D_FF), D_MODEL ** -0.5),
        'w2': nrm(ks[21], (DEPTH, D_FF, D_MODEL), D_FF ** -0.5),
        'final_norm_g': gain(ks[22], (D_MODEL,)),
    }


def reference(x, mem, mix_norm_g, w_in, conv_w, conv_b, mlstm_i_b, mlstm_f_b, mlstm_norm_g,
              gla_wa2, gla_ba, gla_norm_g, w_out, xattn_norm_g, mem_norm_g, wq_x, wk_x, wv_x,
              wo_x, mlp_norm_g, w1, w2, final_norm_g):
    f32 = jnp.float32
    dt = x.dtype
    B, S, _ = x.shape
    M = mem.shape[1]
    for l in range(DEPTH):
        h = rmsnorm(x, mix_norm_g[l])
        u = h @ w_in[l]
        mq, mk, mv, mo, mi, mf, gq, gk, gv, gr, ga = jnp.split(u, IN_SPLIT_IDX, axis=-1)

        qk = jax.nn.silu(causal_conv(jnp.concatenate([mq, mk], axis=-1), conv_w[l], conv_b[l]))
        mq, mk = jnp.split(qk, 2, axis=-1)
        log_i = (mi + mlstm_i_b[l]).astype(f32)
        log_f = jax.nn.log_sigmoid((mf + mlstm_f_b[l]).astype(f32))
        h_m = mlstm_chunkwise(to_chunks((mq * MLSTM_HD ** -0.5).astype(f32), MLSTM_HEADS),
                              to_chunks(mk.astype(f32), MLSTM_HEADS),
                              to_chunks(mv.astype(f32), MLSTM_HEADS),
                              gate_chunks(log_i), gate_chunks(log_f))
        h_m = head_rmsnorm(from_chunks(h_m), mlstm_norm_g[l]).astype(dt) * jax.nn.sigmoid(mo)

        log_a = jax.nn.log_sigmoid((ga @ gla_wa2[l] + gla_ba[l]).astype(f32)) / GLA_TAU
        h_g = gla_chunkwise(to_chunks((gq * GLA_DK ** -0.5).astype(f32), GLA_HEADS),
                            to_chunks(gk.astype(f32), GLA_HEADS),
                            to_chunks(gv.astype(f32), GLA_HEADS),
                            to_chunks(log_a, GLA_HEADS))
        h_g = head_rmsnorm(from_chunks(h_g), gla_norm_g[l]).astype(dt) * jax.nn.silu(gr)

        x = x + jnp.concatenate([h_m, h_g], axis=-1) @ w_out[l]

        hq = (rmsnorm(x, xattn_norm_g[l]) @ wq_x[l]).reshape(B, S, XATTN_HEADS, XATTN_HD)
        mn = rmsnorm(mem, mem_norm_g[l])
        mk_ = (mn @ wk_x[l]).reshape(B, M, XATTN_HEADS, XATTN_HD)
        mv_ = (mn @ wv_x[l]).reshape(B, M, XATTN_HEADS, XATTN_HD)
        scores = jnp.einsum('bshd,bmhd->bhsm', hq, mk_).astype(f32) * (XATTN_HD ** -0.5)
        p = jax.nn.softmax(scores, axis=-1).astype(dt)
        att = jnp.einsum('bhsm,bmhd->bshd', p, mv_).reshape(B, S, D_MODEL)
        x = x + att @ wo_x[l]

        hm = rmsnorm(x, mlp_norm_g[l]) @ w1[l]
        x = x + jnp.square(jax.nn.relu(hm)) @ w2[l]
    return rmsnorm(x, final_norm_g)
```

```cpp
#include <hip/hip_runtime.h>
#include <cstdio>
#include <cstdint>
namespace pg8 {
#define PG8_LAS __attribute__((address_space(3)))
typedef unsigned short bf16_t;
typedef short bf16x8 __attribute__((ext_vector_type(8)));
typedef float f32x4 __attribute__((ext_vector_type(4)));
typedef unsigned u32x4 __attribute__((ext_vector_type(4)));
constexpr int BM = 256, BK = 64, HALF = 128, HTB = HALF * BK * 2  , STAGE_BYTES = 8 * HTB, NXCD = 8, WGM = 8;

__host__ __device__ __forceinline__ int lds_byte(int r, int c) { const int st = (r >> 4) * 2 + (c >> 5), rr = r & 15, cc = c & 31, ob = rr * 64 + cc * 2; return st * 1024 + (ob ^ (((ob >> 9) & 1) << 5)); }
__host__ __device__ __forceinline__ void stage_rc(int b, int& R, int& C) { const int st = b / 1024, sb = b % 1024, swz = sb ^ (((sb >> 9) & 1) << 5); R = (st >> 1) * 16 + swz / 64; C = (st & 1) * 32 + (swz % 64) / 2; }
__host__ __device__ __forceinline__ int perm32(int rho) { const int n = rho >> 4, i = rho & 15; return 8 * (i >> 2) + 4 * n + (i & 3); }


struct Unit { int pm, pn; };
struct Gemm { const bf16_t* A; const bf16_t* Bt; int lda, ldb, K; };

struct StaticOrder {
    int nM, nN, nwg, G, c;
    __host__ __device__ void init(int M, int N, int G_, int c_) { nM = M / BM; nN = N / BM; nwg = nM * nN; G = G_; c = c_; }
    __host__ __device__ bool next(int i, Unit& u) const {
        const long L = (long)i * G + c; if (L >= nwg) return false;
        int wgid = (int)L; { const int q = nwg / NXCD, r = nwg % NXCD, xcd = wgid % NXCD, off = wgid / NXCD; wgid = (xcd < r ? xcd * (q + 1) : r * (q + 1) + (xcd - r) * q) + off; }
        const int nig = WGM * nN, gid = wgid / nig, fm = gid * WGM, gsz = (nM - fm) < WGM ? (nM - fm) : WGM;
        u.pm = fm + ((wgid % nig) % gsz); u.pn = (wgid % nig) / gsz; return true;
    }
    __device__ __forceinline__ const char* aptr(const Gemm& g, const Unit& u) const { return (const char*)g.A + (size_t)u.pm * BM * g.lda * 2; }
    __device__ __forceinline__ const char* bptr(const Gemm& g, const Unit& u) const { return (const char*)g.Bt + (size_t)u.pn * BM * g.ldb * 2; }
    __device__ __forceinline__ void a_ready(const Unit&) const {}
    __device__ __forceinline__ void done(const Unit&) const {}
};
template <int MODE> struct AttnOrder {
    int G, c;
    __device__ bool next(int i, Unit& u) const { const long L = (long)i * G + c; if (L >= 1024) return false; u.pm = (int)(L >> 2); u.pn = (int)(L & 3); return true; }
    __device__ __forceinline__ const char* aptr(const Gemm& g, const Unit& u) const { return (const char*)g.A + ((size_t)u.pm * 256 * 1024 + (size_t)u.pn * 256) * 2; }
    __device__ __forceinline__ const char* bptr(const Gemm& g, const Unit& u) const {
        return MODE == 0 ? (const char*)g.Bt + ((size_t)(u.pm >> 4) * 256 * 1024 + (size_t)u.pn * 256) * 2
                         : (const char*)g.Bt + ((size_t)u.pn * 256 * 4096 + (size_t)(u.pm >> 4) * 256) * 2; }
    __device__ __forceinline__ void a_ready(const Unit&) const {}
    __device__ __forceinline__ void done(const Unit&) const {}
};

__device__ __forceinline__ unsigned cvt_pk_bf16(float lo, float hi) { unsigned r; asm volatile("v_cvt_pk_bf16_f32 %0, %1, %2" : "=v"(r) : "v"(lo), "v"(hi)); return r; }
__device__ __forceinline__ float bf_lo(unsigned w) { return __uint_as_float(w << 16); }
__device__ __forceinline__ float bf_hi(unsigned w) { return __uint_as_float(w & 0xffff0000u); }

template <int RS  , int ACT, int RES, int OUTF32, int SSQ, int GATE>
struct Epi {
    static constexpr bool PERM = true, AFTER_DRAIN = false;
    void* out; int ldc; const float* rs; float scale; const void* base; float* ssp; float* gates;
    __device__ __forceinline__ void operator()(const f32x4 (&acc)[2][2][4][2], const Unit& u, int wr, int wc, int fr, int fq) const {
        const int row0 = u.pm * BM + wr * 64 + fr, col0 = u.pn * BM + wc * 32 + 8 * fq;
        const bool gate_tile = GATE && (u.pn == 14);
#pragma unroll
        for (int ai = 0; ai < 2; ++ai)
#pragma unroll
            for (int m = 0; m < 4; ++m) {
                const int r = row0 + ai * HALF + m * 16;
                float rsv = scale;
                if (RS == 1) rsv *= rs[r];
                if (RS == 2) { const f32x4* p = (const f32x4*)(rs + (size_t)r * 16); const f32x4 a = p[0], b = p[1], c = p[2], d = p[3];
                    const float s = ((a[0] + a[1]) + (a[2] + a[3])) + ((b[0] + b[1]) + (b[2] + b[3])) + ((c[0] + c[1]) + (c[2] + c[3])) + ((d[0] + d[1]) + (d[2] + d[3]));
                    rsv *= 1.0f / sqrtf(s * (1.0f / 1024.0f) + 1e-6f); }
                float ss = 0.f;
#pragma unroll
                for (int bj = 0; bj < 2; ++bj) {
                    f32x4 v0 = acc[ai][bj][m][0] * rsv, v1 = acc[ai][bj][m][1] * rsv;
                    if (ACT == 1) { v0 = __builtin_elementwise_max(v0, (f32x4){0.f, 0.f, 0.f, 0.f}); v1 = __builtin_elementwise_max(v1, (f32x4){0.f, 0.f, 0.f, 0.f}); v0 = v0 * v0; v1 = v1 * v1; }
                    const size_t off = (size_t)r * ldc + col0 + bj * HALF;
                    if (RES == 1) { const f32x4* bp = (const f32x4*)((const float*)base + off); v0 = v0 + bp[0]; v1 = v1 + bp[1]; }
                    if (RES == 2) { const u32x4 w = *(const u32x4*)((const bf16_t*)base + off);
                        v0 = v0 + (f32x4){bf_lo(w.x), bf_hi(w.x), bf_lo(w.y), bf_hi(w.y)}; v1 = v1 + (f32x4){bf_lo(w.z), bf_hi(w.z), bf_lo(w.w), bf_hi(w.w)}; }
                    if (SSQ) ss += ((v0[0] * v0[0] + v0[1] * v0[1]) + (v0[2] * v0[2] + v0[3] * v0[3])) + ((v1[0] * v1[0] + v1[1] * v1[1]) + (v1[2] * v1[2] + v1[3] * v1[3]));
                    if (gate_tile) { if (bj == 0 && wc == 0 && fq < 3) { f32x4* gp = (f32x4*)(gates + (size_t)r * 32 + 8 * fq); gp[0] = v0; gp[1] = v1; } }
                    else if (OUTF32) { f32x4* op = (f32x4*)((float*)out + off); op[0] = v0; op[1] = v1; }
                    else { u32x4 w; w.x = cvt_pk_bf16(v0[0], v0[1]); w.y = cvt_pk_bf16(v0[2], v0[3]); w.z = cvt_pk_bf16(v1[0], v1[1]); w.w = cvt_pk_bf16(v1[2], v1[3]);
                        *(u32x4*)((bf16_t*)out + off) = w; }
                }
                if (SSQ) { ss += __shfl_xor(ss, 16); ss += __shfl_xor(ss, 32); if (fq == 0) ssp[(size_t)r * 16 + u.pn * 4 + wc] = ss; }
                if (RS == 2 || RES != 0) asm volatile("" ::: "memory");
            }
    }
};

template <class Epi, class Sched, bool ALIGN_EPI = false, bool SP2 = false>
__device__ __forceinline__ void gemm_phase(PG8_LAS unsigned char* lds, const Gemm g, const Sched& S, const Epi& E) {
    const int tid = threadIdx.x, wid = __builtin_amdgcn_readfirstlane(tid >> 6), lane = tid & 63, wr = wid >> 2, wc = wid & 3, fr = lane & 15, fq = lane >> 4;
    const int K = g.K, nt = K / BK;
    unsigned voffA[2], voffB[2];
#pragma unroll
    for (int i = 0; i < 2; ++i) { int R, C; stage_rc(tid * 16 + i * 8192, R, C); const int Rb = Epi::PERM ? ((R & ~31) + perm32(R & 31)) : R;
        voffA[i] = (unsigned)(R * g.lda + C) * 2u; voffB[i] = (unsigned)(Rb * g.ldb + C) * 2u; }
    const size_t kstep = (size_t)(BK * 2);
    const size_t hstepA = (size_t)HALF * g.lda * 2, hstepB = (size_t)HALF * g.ldb * 2;
    const unsigned ldsw = (unsigned)wid * 1024u;
    const int aoff = lds_byte(wr * 64 + fr, fq * 8), boff = lds_byte(wc * 32 + fr, fq * 8);
#define PG8_SA(b, h) (((b) * 2 + (h)) * HTB)
#define PG8_SB(b, h) ((4 + (b) * 2 + (h)) * HTB)
#define PG8_STAGE(bufoff, gbase, voff) do { _Pragma("unroll") for (int _i = 0; _i < 2; ++_i) \
        __builtin_amdgcn_global_load_lds((const unsigned*)((const char*)(gbase) + (voff)[_i]), (PG8_LAS unsigned*)(lds + (bufoff) + ldsw + _i * 8192), 16, 0, 0); } while (0)
#define PG8_LDA(dst, b, h) do { _Pragma("unroll") for (int m = 0; m < 4; ++m) _Pragma("unroll") for (int k = 0; k < 2; ++k) dst[m][k] = *(const PG8_LAS bf16x8*)(lds + PG8_SA(b, h) + aoff + m * 2048 + k * 1024); } while (0)
#define PG8_LDB(dst, b, h) do { _Pragma("unroll") for (int n = 0; n < 2; ++n) _Pragma("unroll") for (int k = 0; k < 2; ++k) dst[n][k] = *(const PG8_LAS bf16x8*)(lds + PG8_SB(b, h) + boff + n * 2048 + k * 1024); } while (0)
#define PG8_MMA(ai, bj, At, Bt) do { __builtin_amdgcn_s_setprio(1); _Pragma("unroll") for (int m = 0; m < 4; ++m) _Pragma("unroll") for (int n = 0; n < 2; ++n) _Pragma("unroll") for (int k = 0; k < 2; ++k) \
        acc[ai][bj][m][n] = __builtin_amdgcn_mfma_f32_16x16x32_bf16(Bt[n][k], At[m][k], acc[ai][bj][m][n], 0, 0, 0); __builtin_amdgcn_s_setprio(0); } while (0)
#define PG8_WAIT_V(n) asm volatile("s_waitcnt vmcnt(" #n ")" ::: "memory")
#define PG8_WAIT_L(n) asm volatile("s_waitcnt lgkmcnt(" #n ")" ::: "memory")
#define PG8_BAR __builtin_amdgcn_s_barrier()
#define PG8_SCHED __builtin_amdgcn_sched_barrier(0)
    Unit cur, nxt; int ui = 0;
    if (!S.next(0, cur)) return;
    f32x4 acc[2][2][4][2];
#pragma unroll
    for (int a = 0; a < 2; ++a)
#pragma unroll
        for (int b = 0; b < 2; ++b)
#pragma unroll
            for (int m = 0; m < 4; ++m)
#pragma unroll
                for (int n = 0; n < 2; ++n) acc[a][b][m][n] = (f32x4){0.f, 0.f, 0.f, 0.f};
    bf16x8 At[4][2], B0[2][2], B1[2][2];
    const char* cA = S.aptr(g, cur); const char* cB = S.bptr(g, cur);
    S.a_ready(cur);
    if constexpr (SP2) {
        PG8_STAGE(PG8_SB(0, 0), cB, voffB); PG8_STAGE(PG8_SB(0, 1), cB + hstepB, voffB); PG8_STAGE(PG8_SA(0, 0), cA, voffA); PG8_STAGE(PG8_SA(0, 1), cA + hstepA, voffA);
        if (wr == 1) PG8_BAR;
        PG8_WAIT_V(2); PG8_BAR;
        PG8_STAGE(PG8_SB(1, 0), cB + kstep, voffB); PG8_STAGE(PG8_SA(1, 0), cA + kstep, voffA); PG8_STAGE(PG8_SB(1, 1), cB + hstepB + kstep, voffB);
        PG8_WAIT_V(6); PG8_BAR;
    } else {
        PG8_STAGE(PG8_SB(0, 0), cB, voffB); PG8_STAGE(PG8_SA(0, 0), cA, voffA); PG8_STAGE(PG8_SB(0, 1), cB + hstepB, voffB); PG8_STAGE(PG8_SA(0, 1), cA + hstepA, voffA);
        if (wr == 1) PG8_BAR;
        PG8_WAIT_V(4); PG8_BAR;
        PG8_STAGE(PG8_SB(1, 0), cB + kstep, voffB); PG8_STAGE(PG8_SA(1, 0), cA + kstep, voffA); PG8_STAGE(PG8_SB(1, 1), cB + hstepB + kstep, voffB);
        PG8_WAIT_V(6); PG8_BAR;
    }
    for (;;) {
        const bool has_next = S.next(ui + 1, nxt);
        const char* nA = has_next ? S.aptr(g, nxt) : cA; const char* nB = has_next ? S.bptr(g, nxt) : cB;
        _Pragma("unroll 1") for (int t = 0; t < nt; t += 2) {
            const bool last = (t == nt - 2);
            const char* a1 = cA + (size_t)(t + 1) * kstep;
            const char* a2 = last ? nA : cA + (size_t)(t + 2) * kstep; const char* b2 = last ? nB : cB + (size_t)(t + 2) * kstep;
            const char* a3 = a2 + kstep; const char* b3 = b2 + kstep;
            if (last && has_next) S.a_ready(nxt);
            if constexpr (SP2) {
            PG8_LDB(B0, 0, 0); PG8_LDB(B1, 0, 1); PG8_SCHED; PG8_LDA(At, 0, 0); PG8_STAGE(PG8_SA(1, 1), a1 + hstepA, voffA);
            PG8_WAIT_V(8); PG8_WAIT_L(0); PG8_BAR; PG8_MMA(0, 0, At, B0); PG8_MMA(0, 1, At, B1); PG8_BAR; PG8_SCHED;
            PG8_LDA(At, 0, 1); PG8_STAGE(PG8_SB(0, 0), b2, voffB); PG8_STAGE(PG8_SB(0, 1), b2 + hstepB, voffB); PG8_STAGE(PG8_SA(0, 0), a2, voffA);
            PG8_WAIT_V(8); PG8_WAIT_L(0); PG8_BAR; PG8_MMA(1, 0, At, B0); PG8_MMA(1, 1, At, B1); PG8_BAR; PG8_SCHED;
            PG8_LDB(B0, 1, 0); PG8_LDB(B1, 1, 1); PG8_SCHED; PG8_LDA(At, 1, 0); PG8_STAGE(PG8_SA(0, 1), a2 + hstepA, voffA);
            PG8_WAIT_V(8); PG8_WAIT_L(0); PG8_BAR; PG8_MMA(0, 0, At, B0); PG8_MMA(0, 1, At, B1); PG8_BAR; PG8_SCHED;
            PG8_LDA(At, 1, 1); PG8_STAGE(PG8_SB(1, 0), b3, voffB); PG8_STAGE(PG8_SB(1, 1), b3 + hstepB, voffB); PG8_STAGE(PG8_SA(1, 0), a3, voffA);
            PG8_WAIT_V(8); PG8_WAIT_L(0); PG8_BAR; PG8_MMA(1, 0, At, B0); PG8_MMA(1, 1, At, B1); PG8_BAR; PG8_SCHED;
            } else {
            PG8_LDB(B0, 0, 0); PG8_SCHED; PG8_LDA(At, 0, 0); PG8_STAGE(PG8_SA(1, 1), a1 + hstepA, voffA);
            PG8_WAIT_L(8); PG8_BAR; PG8_WAIT_L(0); PG8_MMA(0, 0, At, B0); PG8_BAR; PG8_SCHED;
            PG8_LDB(B1, 0, 1); PG8_STAGE(PG8_SB(0, 0), b2, voffB);
            PG8_BAR; PG8_WAIT_L(0); PG8_MMA(0, 1, At, B1); PG8_BAR;
            PG8_LDA(At, 0, 1); PG8_STAGE(PG8_SA(0, 0), a2, voffA);
            PG8_BAR; PG8_WAIT_L(0); PG8_MMA(1, 0, At, B0); PG8_BAR; PG8_SCHED;
            PG8_STAGE(PG8_SB(0, 1), b2 + hstepB, voffB);
            PG8_WAIT_V(6); PG8_BAR; PG8_MMA(1, 1, At, B1); PG8_BAR;
            PG8_LDB(B0, 1, 0); PG8_SCHED; PG8_LDA(At, 1, 0); PG8_STAGE(PG8_SA(0, 1), a2 + hstepA, voffA);
            PG8_WAIT_L(8); PG8_BAR; PG8_WAIT_L(0); PG8_MMA(0, 0, At, B0); PG8_BAR; PG8_SCHED;
            PG8_LDB(B1, 1, 1); PG8_STAGE(PG8_SB(1, 0), b3, voffB);
            PG8_BAR; PG8_WAIT_L(0); PG8_MMA(0, 1, At, B1); PG8_BAR;
            PG8_LDA(At, 1, 1); PG8_STAGE(PG8_SA(1, 0), a3, voffA);
            PG8_BAR; PG8_WAIT_L(0); PG8_MMA(1, 0, At, B0); PG8_BAR; PG8_SCHED;
            PG8_STAGE(PG8_SB(1, 1), b3 + hstepB, voffB);
            PG8_WAIT_V(6); PG8_BAR; PG8_MMA(1, 1, At, B1); PG8_BAR;
            }
        }
        if constexpr (ALIGN_EPI) { if (wr == 0) PG8_BAR; }
        if constexpr (!Epi::AFTER_DRAIN) { E(acc, cur, wr, wc, fr, fq); S.done(cur); }
        if (!has_next) break;
#pragma unroll
        for (int a = 0; a < 2; ++a)
#pragma unroll
            for (int b = 0; b < 2; ++b)
#pragma unroll
                for (int m = 0; m < 4; ++m)
#pragma unroll
                    for (int n = 0; n < 2; ++n) acc[a][b][m][n] = (f32x4){0.f, 0.f, 0.f, 0.f};
        cur = nxt; cA = nA; cB = nB; ++ui;
        if constexpr (ALIGN_EPI) { if (wr == 1) PG8_BAR; }
    }
    PG8_WAIT_V(0);
    if constexpr (!ALIGN_EPI) { if (wr == 0) PG8_BAR; }
    PG8_BAR;
    if constexpr (Epi::AFTER_DRAIN) { E.fused(acc, cur, wr, wc, fr, fq, lds, wid, lane); S.done(cur); }
#undef PG8_SA
#undef PG8_SB
#undef PG8_STAGE
#undef PG8_LDA
#undef PG8_LDB
#undef PG8_MMA
#undef PG8_WAIT_V
#undef PG8_WAIT_L
#undef PG8_BAR
#undef PG8_SCHED
}
}

constexpr int NWAVES = 8;
constexpr int BATCH = 16, SEQ = 4096, DM = 1024, T = BATCH * SEQ, MEML = 256, TMEM = BATCH * MEML, DFF = 4096, NU = 3584, NINP = 3840;
constexpr float EPS = 1e-6f;
constexpr size_t MiB = 1u << 20;
constexpr size_t WS_CTL = 0, CTL_ZERO_BYTES = 1 * MiB;
constexpr size_t WS_WIN = 2 * MiB, WS_WOUT = 10 * MiB, WS_WQ = 12 * MiB, WS_WK = 14 * MiB, WS_WV = 16 * MiB, WS_WO = 18 * MiB, WS_W1 = 20 * MiB, WS_W2 = 28 * MiB;
constexpr size_t WS_MEMN = 36 * MiB, WS_KB = 44 * MiB, WS_VT = 52 * MiB, WS_RSTD0 = 60 * MiB, WS_SSP1 = 61 * MiB, WS_SSP2 = 65 * MiB, WS_SSP3 = 69 * MiB;
constexpr size_t WS_GATES = 73 * MiB, WS_LI = 81 * MiB, WS_BF = 82 * MiB, WS_EBL = 83 * MiB;
constexpr size_t WS_XB = 96 * MiB, WS_X1 = 96 * MiB, WS_U = 224 * MiB, WS_QM = 672 * MiB, WS_KM = 736 * MiB, WS_QG = 800 * MiB, WS_KG = 832 * MiB, WS_KW = 864 * MiB;
constexpr size_t WS_HM = 896 * MiB, WS_X2 = 896 * MiB, WS_HQ = 224 * MiB, WS_P = 352 * MiB, WS_ATT = 480 * MiB, WS_HID = 224 * MiB, WS_END = 1024 * MiB;
constexpr int CW_BAR = 4096;
constexpr int RING_BYTES = 131072, MISC_OFF = RING_BYTES + 320, LDS_BYTES = 147456;

#define LAS __attribute__((address_space(3)))
typedef unsigned short bf16;
typedef unsigned v4u __attribute__((ext_vector_type(4)));
typedef unsigned v2u __attribute__((ext_vector_type(2)));
typedef float f32x4 __attribute__((ext_vector_type(4)));
#define LDS_WAIT() asm volatile("s_waitcnt lgkmcnt(0)" ::: "memory")
__device__ __forceinline__ unsigned f2bf(float f) { unsigned u = __builtin_bit_cast(unsigned, f); return (u + 0x7fffu + ((u >> 16) & 1u)) >> 16; }
__device__ __forceinline__ unsigned pk2(float lo, float hi) { return f2bf(lo) | (f2bf(hi) << 16); }
__device__ __forceinline__ float bf2f(bf16 v) { return __uint_as_float((unsigned)v << 16); }
__device__ __forceinline__ float wave_sum(float v) {
#pragma unroll
    for (int o = 1; o < 64; o <<= 1) v += __shfl_xor(v, o);
    return v;
}
__device__ __forceinline__ float wave_max(float v) {
#pragma unroll
    for (int o = 1; o < 64; o <<= 1) v = fmaxf(v, __shfl_xor(v, o));
    return v;
}
__device__ __forceinline__ float logsig(float x) { return fminf(x, 0.f) - log1pf(expf(-fabsf(x))); }

#define XB_TMO      128
#define XB_XCNT(j)  (256  + 64 * (j))
#define XB_XSUB(j)  (1280 + 64 * (j))
#define XB_XGEN(j)  (2304 + 64 * (j))
#define XB_TOP      3328
#define XB_TOPGEN   3392
#define XCD_BAR_WORDS 3456
#define XB_SPIN_CAP (1u << 18)

__device__ __forceinline__ unsigned xb_ld(unsigned* p)              { return __hip_atomic_load(p, __ATOMIC_RELAXED, __HIP_MEMORY_SCOPE_AGENT); }
__device__ __forceinline__ unsigned xb_add(unsigned* p, unsigned v) { return __hip_atomic_fetch_add(p, v, __ATOMIC_RELAXED, __HIP_MEMORY_SCOPE_AGENT); }
__device__ __forceinline__ unsigned xb_xcc_id() { return (unsigned)__builtin_amdgcn_s_getreg((3 << 11) | 20) & 0xFu; }
#define XB_SPIN(cond, bar) do { unsigned _sp = 0; while (cond) { __builtin_amdgcn_s_sleep(1); \
    if ((++_sp & 255u) == 0u) { if (xb_ld(&(bar)[XB_TMO])) break; if (_sp > XB_SPIN_CAP) { atomicAdd(&(bar)[XB_TMO], 1u); break; } } } } while (0)

struct XcdBarrier {
    unsigned* bar; unsigned x;
    volatile LAS unsigned* st;
};

__device__ __forceinline__ XcdBarrier xcd_barrier_post(unsigned* bar, volatile LAS unsigned* st) {
    XcdBarrier b; b.bar = bar; b.x = xb_xcc_id(); b.st = st;
    if (threadIdx.x == 0) (void)xb_add(&bar[XB_XCNT(b.x)], 1u);
    return b;
}
__device__ __forceinline__ void xcd_barrier_complete(unsigned* bar, unsigned x, unsigned& nloc, unsigned& nx) {
    const unsigned G = gridDim.x * gridDim.y * gridDim.z;
    unsigned sum, cnt, mine, sp = 0u;
    for (;;) {
        sum = 0u; cnt = 0u; mine = 0u;
#pragma unroll
        for (unsigned j = 0; j < 16; ++j) { const unsigned c = xb_ld(&bar[XB_XCNT(j)]); sum += c; cnt += (c > 0u) ? 1u : 0u; mine = (j == x) ? c : mine; }
        if (sum == G) break;
        __builtin_amdgcn_s_sleep(1);
        if ((++sp & 255u) == 0u) { if (xb_ld(&bar[XB_TMO])) break; if (sp > XB_SPIN_CAP) { atomicAdd(&bar[XB_TMO], 1u); break; } }
    }
    nloc = mine > 0u ? mine : 1u; nx = cnt > 0u ? cnt : 1u;
}

__device__ __forceinline__ void xcd_barrier(const XcdBarrier& b) {
    asm volatile("s_waitcnt vmcnt(0)" ::: "memory");
    __syncthreads();
    if (threadIdx.x == 0) {
        unsigned* bar = b.bar;
        __builtin_amdgcn_s_waitcnt(0);
        unsigned nloc = b.st[0], nx = b.st[1];
        if (nloc == 0u) { xcd_barrier_complete(bar, b.x, nloc, nx); b.st[0] = nloc; b.st[1] = nx; }
        const unsigned old = xb_add(&bar[XB_XSUB(b.x)], 1u);
        const unsigned gen = old / nloc;
        if (old + 1u == (gen + 1u) * nloc) {
            __builtin_amdgcn_fence(__ATOMIC_RELEASE, "agent");
            asm volatile("s_waitcnt vmcnt(0)" ::: "memory");
            const unsigned og = xb_add(&bar[XB_TOP], 1u);
            const unsigned tg = og / nx;
            if (og + 1u == (tg + 1u) * nx) xb_add(&bar[XB_TOPGEN], 1u);
            else XB_SPIN(xb_ld(&bar[XB_TOPGEN]) == tg, bar);
            __builtin_amdgcn_fence(__ATOMIC_ACQUIRE, "agent");
            xb_add(&bar[XB_XGEN(b.x)], 1u);
            asm volatile("s_waitcnt vmcnt(0)" ::: "memory");
        } else {
            XB_SPIN(xb_ld(&bar[XB_XGEN(b.x)]) == gen, bar);
            __builtin_amdgcn_fence(__ATOMIC_ACQUIRE, "agent");
            asm volatile("s_waitcnt vmcnt(0)" ::: "memory");
        }
    }
    __syncthreads();
}

struct Args { const float* in[23]; float* out; unsigned char* ws; int ph_lo, ph_hi; };
enum { I_X = 0, I_MEM, I_MIXG, I_WIN, I_CONVW, I_CONVB, I_IB, I_FB, I_MNG, I_WA2, I_BA, I_GNG, I_WOUT, I_XAG, I_MEMG, I_WQ, I_WK, I_WV, I_WO, I_MLPG, I_W1, I_W2, I_FING };

__device__ __forceinline__ int map_col(int mode, int nd) {
    if (mode == 0) return nd;
    if (nd < 2048) return nd; if (nd < 3584) return nd + 8; if (nd < 3592) return nd - 3584 + 2048; if (nd < 3608) return nd; return -1;
}
__device__ __forceinline__ void p0_transpose_item(const float* W, int K, int N, const float* gain, bf16* WT, int ndst_blk, int mode, LAS float* scr, int item, int lane) {
    const int kb = item / ndst_blk, nb = item % ndst_blk, k0 = 64 * kb, n0 = 32 * nb;
    const int ns = map_col(mode, n0 + (lane & 31));
#pragma unroll 8
    for (int i = 0; i < 32; ++i) { const int kk = 2 * i + (lane >> 5); float v = 0.f; if (ns >= 0) { v = W[(size_t)(k0 + kk) * N + ns]; if (gain) v *= gain[k0 + kk]; } scr[kk * 33 + (lane & 31)] = v; }
    LDS_WAIT(); asm volatile("" ::: "memory");
    const int c = lane & 7;
#pragma unroll
    for (int j = 0; j < 4; ++j) { const int n = (lane >> 3) + 8 * j; const LAS float* s = scr + (8 * c) * 33 + n;
        v4u o; o.x = pk2(s[0 * 33], s[1 * 33]); o.y = pk2(s[2 * 33], s[3 * 33]); o.z = pk2(s[4 * 33], s[5 * 33]); o.w = pk2(s[6 * 33], s[7 * 33]);
        *(v4u*)(WT + (size_t)(n0 + n) * K + k0 + 8 * c) = o; }
    LDS_WAIT(); asm volatile("" ::: "memory");
}

__device__ __forceinline__ void phase_prologue(const Args& a, LAS unsigned char* lds, int G) {
    const int tid = threadIdx.x, lane = tid & 63, wave = tid >> 6;
    unsigned char* ws = a.ws;
    LAS float* scr = (LAS float*)(lds + wave * 16384);
    const int gw = blockIdx.x * NWAVES + wave, NGW = G * NWAVES;
    constexpr int I_IN = 16 * 120, I_SQ = 16 * 32, I_1 = 16 * 128, I_2 = 64 * 32;
    constexpr int NITEMS = I_IN + 5 * I_SQ + I_1 + I_2;
    for (int it = gw; it < NITEMS; it += NGW) {
        int r = it;
        if (r < I_IN) { p0_transpose_item(a.in[I_WIN], 1024, 3608, a.in[I_MIXG], (bf16*)(ws + WS_WIN), 120, 1, scr, r, lane); continue; } r -= I_IN;
        if (r < I_SQ) { p0_transpose_item(a.in[I_WOUT], 1024, 1024, nullptr, (bf16*)(ws + WS_WOUT), 32, 0, scr, r, lane); continue; } r -= I_SQ;
        if (r < I_SQ) { p0_transpose_item(a.in[I_WQ], 1024, 1024, a.in[I_XAG], (bf16*)(ws + WS_WQ), 32, 0, scr, r, lane); continue; } r -= I_SQ;
        if (r < I_SQ) { p0_transpose_item(a.in[I_WK], 1024, 1024, a.in[I_MEMG], (bf16*)(ws + WS_WK), 32, 0, scr, r, lane); continue; } r -= I_SQ;
        if (r < I_SQ) { p0_transpose_item(a.in[I_WV], 1024, 1024, a.in[I_MEMG], (bf16*)(ws + WS_WV), 32, 0, scr, r, lane); continue; } r -= I_SQ;
        if (r < I_SQ) { p0_transpose_item(a.in[I_WO], 1024, 1024, nullptr, (bf16*)(ws + WS_WO), 32, 0, scr, r, lane); continue; } r -= I_SQ;
        if (r < I_1) { p0_transpose_item(a.in[I_W1], 1024, 4096, a.in[I_MLPG], (bf16*)(ws + WS_W1), 128, 0, scr, r, lane); continue; } r -= I_1;
        p0_transpose_item(a.in[I_W2], 4096, 1024, nullptr, (bf16*)(ws + WS_W2), 32, 0, scr, r, lane);
    }
    const float* x = a.in[I_X]; bf16* XB = (bf16*)(ws + WS_XB); float* rstd0 = (float*)(ws + WS_RSTD0);
    for (int m = gw; m < T; m += NGW) {
        const f32x4* xr = (const f32x4*)(x + (size_t)m * DM) + lane; f32x4 v[4]; float s = 0.f;
#pragma unroll
        for (int j = 0; j < 4; ++j) { v[j] = xr[64 * j]; s += (v[j].x * v[j].x + v[j].y * v[j].y) + (v[j].z * v[j].z + v[j].w * v[j].w); }
        s = wave_sum(s);
        if (lane == 0) rstd0[m] = 1.0f / sqrtf(s * (1.0f / DM) + EPS);
        v2u* o8 = (v2u*)(XB + (size_t)m * DM) + lane;
#pragma unroll
        for (int j = 0; j < 4; ++j) o8[64 * j] = (v2u){pk2(v[j].x, v[j].y), pk2(v[j].z, v[j].w)};
    }
    const float* mem = a.in[I_MEM]; bf16* MEMN = (bf16*)(ws + WS_MEMN);
    for (int m = gw; m < TMEM; m += NGW) {
        const f32x4* xr = (const f32x4*)(mem + (size_t)m * DM) + lane; f32x4 v[4]; float s = 0.f;
#pragma unroll
        for (int j = 0; j < 4; ++j) { v[j] = xr[64 * j]; s += (v[j].x * v[j].x + v[j].y * v[j].y) + (v[j].z * v[j].z + v[j].w * v[j].w); }
        s = wave_sum(s);
        const float rs = 1.0f / sqrtf(s * (1.0f / DM) + EPS);
        v2u* o8 = (v2u*)(MEMN + (size_t)m * DM) + lane;
#pragma unroll
        for (int j = 0; j < 4; ++j) o8[64 * j] = (v2u){pk2(v[j].x * rs, v[j].y * rs), pk2(v[j].z * rs, v[j].w * rs)};
    }
}

__device__ __forceinline__ void phase_prep(const Args& a, LAS unsigned char* lds, int G) {
    const int tid = threadIdx.x;
    unsigned char* ws = a.ws;
    const bf16* U = (const bf16*)(ws + WS_U); const float* gates = (const float*)(ws + WS_GATES);
    bf16* QM = (bf16*)(ws + WS_QM); bf16* KM = (bf16*)(ws + WS_KM); bf16* QG = (bf16*)(ws + WS_QG); bf16* KG = (bf16*)(ws + WS_KG); bf16* KW = (bf16*)(ws + WS_KW);
    float* LI = (float*)(ws + WS_LI); float* BF = (float*)(ws + WS_BF); float* EBL = (float*)(ws + WS_EBL);
    LAS float* gl = (LAS float*)lds;
    LAS float* BL = gl + 64 * 32;
    for (int ci = blockIdx.x; ci < T / 64; ci += G) {
        const size_t t0 = (size_t)ci * 64; const bool first = (ci & 63) == 0;
        ((LAS f32x4*)gl)[tid] = ((const f32x4*)(gates + t0 * 32))[tid];
        __syncthreads();
        {
            const int cg = tid & 127, tg = tid >> 7, c0 = cg * 8, tl0 = tg * 16;
            const float* cw = a.in[I_CONVW]; const float* cb = a.in[I_CONVB];
            float w0[8], w1[8], w2[8], w3[8], bb[8], xm3[8], xm2[8], xm1[8];
#pragma unroll
            for (int i = 0; i < 8; ++i) { w0[i] = cw[c0 + i]; w1[i] = cw[1024 + c0 + i]; w2[i] = cw[2048 + c0 + i]; w3[i] = cw[3072 + c0 + i]; bb[i] = cb[c0 + i]; }
            {
                v4u r3 = {0, 0, 0, 0}, r2 = {0, 0, 0, 0}, r1 = {0, 0, 0, 0};
                if (tl0 > 0 || !first) { r3 = *(const v4u*)(U + (t0 + tl0 - 3) * NU + c0); r2 = *(const v4u*)(U + (t0 + tl0 - 2) * NU + c0); r1 = *(const v4u*)(U + (t0 + tl0 - 1) * NU + c0); }
                xm3[0] = pg8::bf_lo(r3.x); xm3[1] = pg8::bf_hi(r3.x); xm3[2] = pg8::bf_lo(r3.y); xm3[3] = pg8::bf_hi(r3.y); xm3[4] = pg8::bf_lo(r3.z); xm3[5] = pg8::bf_hi(r3.z); xm3[6] = pg8::bf_lo(r3.w); xm3[7] = pg8::bf_hi(r3.w);
                xm2[0] = pg8::bf_lo(r2.x); xm2[1] = pg8::bf_hi(r2.x); xm2[2] = pg8::bf_lo(r2.y); xm2[3] = pg8::bf_hi(r2.y); xm2[4] = pg8::bf_lo(r2.z); xm2[5] = pg8::bf_hi(r2.z); xm2[6] = pg8::bf_lo(r2.w); xm2[7] = pg8::bf_hi(r2.w);
                xm1[0] = pg8::bf_lo(r1.x); xm1[1] = pg8::bf_hi(r1.x); xm1[2] = pg8::bf_lo(r1.y); xm1[3] = pg8::bf_hi(r1.y); xm1[4] = pg8::bf_lo(r1.z); xm1[5] = pg8::bf_hi(r1.z); xm1[6] = pg8::bf_lo(r1.w); xm1[7] = pg8::bf_hi(r1.w);
            }
            const float qs = (c0 < 512) ? 0.08838834764831845f : 1.0f;
            bf16* dst = (c0 < 512) ? (QM + c0) : (KM + (c0 - 512));
            for (int tt = 0; tt < 16; ++tt) {
                const size_t t = t0 + tl0 + tt;
                const v4u rc = *(const v4u*)(U + t * NU + c0);
                float xc[8] = {pg8::bf_lo(rc.x), pg8::bf_hi(rc.x), pg8::bf_lo(rc.y), pg8::bf_hi(rc.y), pg8::bf_lo(rc.z), pg8::bf_hi(rc.z), pg8::bf_lo(rc.w), pg8::bf_hi(rc.w)};
                float y[8];
#pragma unroll
                for (int i = 0; i < 8; ++i) { const float v = bb[i] + w0[i] * xm3[i] + w1[i] * xm2[i] + w2[i] * xm1[i] + w3[i] * xc[i]; y[i] = qs * v / (1.0f + expf(-v)); xm3[i] = xm2[i]; xm2[i] = xm1[i]; xm1[i] = xc[i]; }
                *(v4u*)(dst + t * 512) = (v4u){pk2(y[0], y[1]), pk2(y[2], y[3]), pk2(y[4], y[5]), pk2(y[6], y[7])};
            }
        }
        if (tid < 4) {
            const int h = tid; const float ib = a.in[I_IB][h], fb = a.in[I_FB][h]; float run = 0.f;
            for (int t = 0; t < 64; ++t) { const float li = gl[t * 32 + h] + ib; run += logsig(gl[t * 32 + 4 + h] + fb); LI[(t0 + t) * 4 + h] = li; BF[(t0 + t) * 4 + h] = run; }
        }
        if (tid >= 256) {
            const int c = tid - 256; const float* wa2 = a.in[I_WA2]; float w[16];
#pragma unroll
            for (int r = 0; r < 16; ++r) w[r] = wa2[r * 256 + c];
            const float ba = a.in[I_BA][c]; float run = 0.f;
            for (int t = 0; t < 64; ++t) { float xa = ba;
#pragma unroll
                for (int r = 0; r < 16; ++r) xa += gl[t * 32 + 8 + r] * w[r];
                run += logsig(xa) * (1.0f / 16.0f); BL[t * 256 + c] = run; }
        }
        __syncthreads();
        {
            const int c8 = (tid & 31) * 8;
#pragma unroll
            for (int i = 0; i < 4; ++i) { const int t = (tid >> 5) + 16 * i;
                const v4u rq = *(const v4u*)(U + (t0 + t) * NU + 2048 + c8), rk = *(const v4u*)(U + (t0 + t) * NU + 2304 + c8);
                const float q[8] = {pg8::bf_lo(rq.x), pg8::bf_hi(rq.x), pg8::bf_lo(rq.y), pg8::bf_hi(rq.y), pg8::bf_lo(rq.z), pg8::bf_hi(rq.z), pg8::bf_lo(rq.w), pg8::bf_hi(rq.w)};
                const float k[8] = {pg8::bf_lo(rk.x), pg8::bf_hi(rk.x), pg8::bf_lo(rk.y), pg8::bf_hi(rk.y), pg8::bf_lo(rk.z), pg8::bf_hi(rk.z), pg8::bf_lo(rk.w), pg8::bf_hi(rk.w)};
                float oq[8], ok[8], ow[8];
#pragma unroll
                for (int j = 0; j < 8; ++j) { const float b = BL[t * 256 + c8 + j], bL = BL[63 * 256 + c8 + j]; oq[j] = q[j] * 0.125f * expf(b); ok[j] = k[j] * expf(-b); ow[j] = k[j] * expf(bL - b); }
                *(v4u*)(QG + (t0 + t) * 256 + c8) = (v4u){pk2(oq[0], oq[1]), pk2(oq[2], oq[3]), pk2(oq[4], oq[5]), pk2(oq[6], oq[7])};
                *(v4u*)(KG + (t0 + t) * 256 + c8) = (v4u){pk2(ok[0], ok[1]), pk2(ok[2], ok[3]), pk2(ok[4], ok[5]), pk2(ok[6], ok[7])};
                *(v4u*)(KW + (t0 + t) * 256 + c8) = (v4u){pk2(ow[0], ow[1]), pk2(ow[2], ow[3]), pk2(ow[4], ow[5]), pk2(ow[6], ow[7])};
            }
            if (tid < 256) EBL[(size_t)ci * 256 + tid] = expf(BL[63 * 256 + tid]);
        }
        __syncthreads();
    }
}

__device__ __forceinline__ void mlstm_scalar(LAS unsigned char* lds, int b, int h, const bf16* QM, const bf16* KM, const bf16* U, const float* LI, const float* BF, const float* gnorm, bf16* HM) {
    const int tid = threadIdx.x;
    LAS bf16* qs = (LAS bf16*)lds;
    LAS bf16* ks = qs + 64 * 136;
    LAS bf16* vs = ks + 64 * 136;
    LAS float* Ss = (LAS float*)(lds + 52224);
    LAS float* Cs = (LAS float*)(lds + 68864);
    LAS float* ns = (LAS float*)(lds + 134400);
    LAS float* bs = ns + 128; LAS float* lis = bs + 64; LAS float* wint = lis + 64; LAS float* dinv = wint + 64; LAS float* wgs = dinv + 64;
    LAS float* hs = (LAS float*)lds;
    for (int i = tid; i < 128 * 128; i += 512) Cs[i] = 0.f;
    if (tid < 128) ns[tid] = 0.f;
    float m = 0.f;
    __syncthreads();
    for (int c = 0; c < 64; ++c) {
        const size_t t0 = (size_t)b * SEQ + (size_t)c * 64;
        for (int i = tid; i < 1024; i += 512) { const int t = i >> 4, cc = i & 15;
            *(LAS v4u*)(qs + t * 136 + cc * 8) = *(const v4u*)(QM + (t0 + t) * 512 + h * 128 + cc * 8);
            *(LAS v4u*)(ks + t * 136 + cc * 8) = *(const v4u*)(KM + (t0 + t) * 512 + h * 128 + cc * 8);
            *(LAS v4u*)(vs + t * 136 + cc * 8) = *(const v4u*)(U + (t0 + t) * NU + 1024 + h * 128 + cc * 8); }
        if (tid < 64) { bs[tid] = BF[(t0 + tid) * 4 + h]; lis[tid] = LI[(t0 + tid) * 4 + h]; }
        __syncthreads();
        { const int t = tid >> 3, sg = tid & 7;
            for (int i = 0; i < 8; ++i) { const int s = sg + 8 * i; if (s <= t) { float acc = 0.f; _Pragma("unroll 1") for (int d = 0; d < 128; ++d) acc += bf2f(qs[t * 136 + d]) * bf2f(ks[s * 136 + d]); Ss[t * 65 + s] = acc; } } }
        __syncthreads();
        if (tid < 64) { const int t = tid; const float bt = bs[t]; float mloc = bt + m;
            _Pragma("unroll 1") for (int s = 0; s <= t; ++s) mloc = fmaxf(mloc, bt - bs[s] + lis[s]);
            float rowsum = 0.f;
            _Pragma("unroll 1") for (int s = 0; s <= t; ++s) { const float v = Ss[t * 65 + s] * expf(bt - bs[s] + lis[s] - mloc); Ss[t * 65 + s] = v; rowsum += v; }
            const float wi = expf(bt + m - mloc); float qn = 0.f;
            _Pragma("unroll 1") for (int d = 0; d < 128; ++d) qn += bf2f(qs[t * 136 + d]) * ns[d];
            const float den = rowsum + wi * qn;
            dinv[t] = 1.0f / fmaxf(fabsf(den), expf(-mloc)); wint[t] = wi; }
        __syncthreads();
        { const int t = tid >> 3, j = tid & 7; float vals[16], qc[16];
#pragma unroll
            for (int k = 0; k < 16; ++k) { vals[k] = 0.f; qc[k] = 0.f; }
            _Pragma("unroll 1") for (int s = 0; s <= t; ++s) { const float sv = Ss[t * 65 + s];
#pragma unroll
                for (int k = 0; k < 16; ++k) vals[k] += sv * bf2f(vs[s * 136 + j * 16 + k]); }
            _Pragma("unroll 1") for (int d = 0; d < 128; ++d) { const float qd = bf2f(qs[t * 136 + d]);
#pragma unroll
                for (int k = 0; k < 16; ++k) qc[k] += qd * Cs[d * 128 + j * 16 + k]; }
            const float wi = wint[t], di = dinv[t]; float ss = 0.f;
#pragma unroll
            for (int k = 0; k < 16; ++k) { vals[k] = (vals[k] + wi * qc[k]) * di; ss += vals[k] * vals[k]; }
            ss += __shfl_xor(ss, 1); ss += __shfl_xor(ss, 2); ss += __shfl_xor(ss, 4);
            const float rstd = 1.0f / sqrtf(ss * (1.0f / 128.0f) + EPS);
#pragma unroll
            for (int k = 0; k < 16; ++k) { const int col = h * 128 + j * 16 + k; const float mo = bf2f(U[(t0 + t) * NU + 1536 + col]);
                HM[(t0 + t) * 1024 + col] = (bf16)f2bf(vals[k] * rstd * gnorm[col] * (1.0f / (1.0f + expf(-mo)))); } }
        __syncthreads();
        const float bL = bs[63]; float m_new = bL + m;
        _Pragma("unroll 1") for (int s = 0; s < 64; ++s) m_new = fmaxf(m_new, bL - bs[s] + lis[s]);
        const float decay = expf(bL + m - m_new);
        if (tid < 64) wgs[tid] = expf(bL - bs[tid] + lis[tid] - m_new);
        __syncthreads();
        { const int e = tid & 127, dg = tid >> 7;
            _Pragma("unroll 1") for (int dd = 0; dd < 32; ++dd) { const int d = dg * 32 + dd; float acc = decay * Cs[d * 128 + e];
                _Pragma("unroll 1") for (int s = 0; s < 64; ++s) acc += wgs[s] * bf2f(ks[s * 136 + d]) * bf2f(vs[s * 136 + e]);
                Cs[d * 128 + e] = acc; } }
        if (tid < 128) { const int d = tid; float acc = decay * ns[d]; _Pragma("unroll 1") for (int s = 0; s < 64; ++s) acc += wgs[s] * bf2f(ks[s * 136 + d]); ns[d] = acc; }
        m = m_new;
        __syncthreads();
    }
}
__device__ __forceinline__ void gla_scalar(LAS unsigned char* lds, int b, int h, const bf16* QG, const bf16* KG, const bf16* KW, const bf16* U, const float* EBL, const float* gnorm, bf16* HM) {
    const int tid = threadIdx.x;
    LAS bf16* qg = (LAS bf16*)lds;
    LAS bf16* kg = qg + 64 * 72; LAS bf16* kw = kg + 64 * 72;
    LAS bf16* vs = kw + 64 * 72;
    LAS float* As = (LAS float*)(lds + 45056);
    LAS float* St = (LAS float*)(lds + 61696);
    LAS float* ebl = (LAS float*)(lds + 94464);
    LAS float* hs = (LAS float*)lds;
    for (int i = tid; i < 64 * 128; i += 512) St[i] = 0.f;
    __syncthreads();
    for (int c = 0; c < 64; ++c) {
        const size_t t0 = (size_t)b * SEQ + (size_t)c * 64;
        { const int t = tid >> 3, cc = tid & 7;
            *(LAS v4u*)(qg + t * 72 + cc * 8) = *(const v4u*)(QG + (t0 + t) * 256 + h * 64 + cc * 8);
            *(LAS v4u*)(kg + t * 72 + cc * 8) = *(const v4u*)(KG + (t0 + t) * 256 + h * 64 + cc * 8);
            *(LAS v4u*)(kw + t * 72 + cc * 8) = *(const v4u*)(KW + (t0 + t) * 256 + h * 64 + cc * 8); }
        for (int i = tid; i < 1024; i += 512) { const int t = i >> 4, cc = i & 15; *(LAS v4u*)(vs + t * 136 + cc * 8) = *(const v4u*)(U + (t0 + t) * NU + 2560 + h * 128 + cc * 8); }
        if (tid < 64) ebl[tid] = EBL[((size_t)b * 64 + c) * 256 + h * 64 + tid];
        __syncthreads();
        { const int t = tid >> 3, sg = tid & 7;
            for (int i = 0; i < 8; ++i) { const int s = sg + 8 * i; if (s <= t) { float acc = 0.f; _Pragma("unroll 1") for (int d = 0; d < 64; ++d) acc += bf2f(qg[t * 72 + d]) * bf2f(kg[s * 72 + d]); As[t * 65 + s] = acc; } } }
        __syncthreads();
        { const int t = tid >> 3, j = tid & 7; float vals[16];
#pragma unroll
            for (int k = 0; k < 16; ++k) vals[k] = 0.f;
            _Pragma("unroll 1") for (int s = 0; s <= t; ++s) { const float sv = As[t * 65 + s];
#pragma unroll
                for (int k = 0; k < 16; ++k) vals[k] += sv * bf2f(vs[s * 136 + j * 16 + k]); }
            _Pragma("unroll 1") for (int d = 0; d < 64; ++d) { const float qd = bf2f(qg[t * 72 + d]);
#pragma unroll
                for (int k = 0; k < 16; ++k) vals[k] += qd * St[d * 128 + j * 16 + k]; }
            float ss = 0.f;
#pragma unroll
            for (int k = 0; k < 16; ++k) ss += vals[k] * vals[k];
            ss += __shfl_xor(ss, 1); ss += __shfl_xor(ss, 2); ss += __shfl_xor(ss, 4);
            const float rstd = 1.0f / sqrtf(ss * (1.0f / 128.0f) + EPS);
#pragma unroll
            for (int k = 0; k < 16; ++k) { const int col = h * 128 + j * 16 + k; const float gr = bf2f(U[(t0 + t) * NU + 3072 + col]);
                HM[(t0 + t) * 1024 + 512 + col] = (bf16)f2bf(vals[k] * rstd * gnorm[col] * (gr / (1.0f + expf(-gr)))); } }
        __syncthreads();
        { const int e = tid & 127, dg = tid >> 7;
            _Pragma("unroll 1") for (int dd = 0; dd < 16; ++dd) { const int d = dg * 16 + dd; float acc = ebl[d] * St[d * 128 + e];
                _Pragma("unroll 1") for (int s = 0; s < 64; ++s) acc += bf2f(kw[s * 72 + d]) * bf2f(vs[s * 136 + e]);
                St[d * 128 + e] = acc; } }
        __syncthreads();
    }
}
__device__ __forceinline__ void phase_mixers_scalar(const Args& a, LAS unsigned char* lds, int G) {
    unsigned char* ws = a.ws;
    for (int w = blockIdx.x; w < 128; w += G) {
        if (w < 64) mlstm_scalar(lds, w >> 2, w & 3, (const bf16*)(ws + WS_QM), (const bf16*)(ws + WS_KM), (const bf16*)(ws + WS_U), (const float*)(ws + WS_LI), (const float*)(ws + WS_BF), a.in[I_MNG], (bf16*)(ws + WS_HM));
        else gla_scalar(lds, (w - 64) >> 2, (w - 64) & 3, (const bf16*)(ws + WS_QG), (const bf16*)(ws + WS_KG), (const bf16*)(ws + WS_KW), (const bf16*)(ws + WS_U), (const float*)(ws + WS_EBL), a.in[I_GNG], (bf16*)(ws + WS_HM));
        __syncthreads();
    }
}
__device__ __forceinline__ void phase_softmax(const float* SC, bf16* P, int G) {
    const int lane = threadIdx.x & 63, wave = threadIdx.x >> 6, gw = blockIdx.x * NWAVES + wave, NGW = G * NWAVES;
    for (int r = gw; r < T * 4; r += NGW) {
        const f32x4 v = *((const f32x4*)(SC + (size_t)r * 256) + lane);
        const float mx = wave_max(fmaxf(fmaxf(v.x, v.y), fmaxf(v.z, v.w)));
        const float e0 = expf(v.x - mx), e1 = expf(v.y - mx), e2 = expf(v.z - mx), e3 = expf(v.w - mx);
        const float inv = 1.0f / wave_sum((e0 + e1) + (e2 + e3));
        *((v2u*)(P + (size_t)r * 256) + lane) = (v2u){pk2(e0 * inv, e1 * inv), pk2(e2 * inv, e3 * inv)};
    }
}
__device__ __forceinline__ void phase_final(float* out, const float* ssp, const float* g, int G) {
    const int lane = threadIdx.x & 63, wave = threadIdx.x >> 6, gw = blockIdx.x * NWAVES + wave, NGW = G * NWAVES;
    f32x4 gv[4];
#pragma unroll
    for (int j = 0; j < 4; ++j) gv[j] = ((const f32x4*)g)[lane + 64 * j];
    for (int m = gw; m < T; m += NGW) {
        const float s = wave_sum(lane < 16 ? ssp[(size_t)m * 16 + lane] : 0.f);
        const float rs = 1.0f / sqrtf(s * (1.0f / DM) + EPS);
        f32x4* xr = (f32x4*)(out + (size_t)m * DM) + lane;
#pragma unroll
        for (int j = 0; j < 4; ++j) { f32x4 v = xr[64 * j]; xr[64 * j] = v * rs * gv[j]; }
    }
}

#ifndef MK_N_LAUNCHES
#define MK_N_LAUNCHES 13
#endif
constexpr int NPHASES = 13;
__global__ void __launch_bounds__(NWAVES * 64, 2) fwd_kernel(Args args) {
    extern __shared__ __attribute__((aligned(16))) unsigned char lds_raw[];
    LAS unsigned char* lds = (LAS unsigned char*)lds_raw;
    const int tid = threadIdx.x, G = gridDim.x, bid = blockIdx.x;
    unsigned char* ws = args.ws;
    volatile LAS unsigned* MISC = (volatile LAS unsigned*)(lds + MISC_OFF);
    for (int u = tid; u < (LDS_BYTES - RING_BYTES) / 4; u += NWAVES * 64) ((LAS unsigned*)(lds + RING_BYTES))[u] = 0u;
    __syncthreads();
    XcdBarrier bar; bar.bar = (unsigned*)(ws + WS_CTL) + CW_BAR; bar.x = 0; bar.st = nullptr;
    if (MK_N_LAUNCHES == 1) bar = xcd_barrier_post((unsigned*)(ws + WS_CTL) + CW_BAR, MISC + 8);
    const int lo = args.ph_lo, hi = args.ph_hi;
#ifndef PH_MASK
#define PH_MASK 0x1fff
#endif
#define IN(k) (((PH_MASK >> (k)) & 1) && lo <= (k) && (k) < hi)
#define SEAM(k) do { if (IN(k) && IN((k) + 1)) xcd_barrier(bar); } while (0)
    using namespace pg8;
    const bf16_t* XB = (const bf16_t*)(ws + WS_XB);
    if (IN(0)) { phase_prologue(args, lds, G); SEAM(0); }
    if (IN(1)) {
        { Gemm g{XB, (const bf16_t*)(ws + WS_WIN), 1024, 1024, 1024}; StaticOrder S; S.init(T, NINP, G, bid);
          typedef Epi<1, 0, 0, 0, 0, 1> E_t; E_t E{(void*)(ws + WS_U), NU, (const float*)(ws + WS_RSTD0), 1.f, nullptr, nullptr, (float*)(ws + WS_GATES)};
          gemm_phase<E_t, StaticOrder, true, true>(lds, g, S, E); }
        { Gemm g{(const bf16_t*)(ws + WS_MEMN), (const bf16_t*)(ws + WS_WK), 1024, 1024, 1024}; StaticOrder S; S.init(TMEM, 1024, G, bid);
          typedef Epi<0, 0, 0, 0, 0, 0> E_t; E_t E{(void*)(ws + WS_KB), 1024, nullptr, 1.f, nullptr, nullptr, nullptr};
          gemm_phase<E_t, StaticOrder, true, true>(lds, g, S, E); }
        { Gemm g{(const bf16_t*)(ws + WS_WV), (const bf16_t*)(ws + WS_MEMN), 1024, 1024, 1024}; StaticOrder S; S.init(1024, TMEM, G, bid);
          typedef Epi<0, 0, 0, 0, 0, 0> E_t; E_t E{(void*)(ws + WS_VT), 4096, nullptr, 1.f, nullptr, nullptr, nullptr};
          gemm_phase<E_t, StaticOrder, true, true>(lds, g, S, E); }
        SEAM(1);
    }
    if (IN(2)) { phase_prep(args, lds, G); SEAM(2); }
    if (IN(3)) { phase_mixers_scalar(args, lds, G); SEAM(3); }
    if (IN(4)) {
        Gemm g{(const bf16_t*)(ws + WS_HM), (const bf16_t*)(ws + WS_WOUT), 1024, 1024, 1024}; StaticOrder S; S.init(T, 1024, G, bid);
        typedef Epi<0, 0, 1, 0, 1, 0> E_t; E_t E{(void*)(ws + WS_X1), 1024, nullptr, 1.f, (const void*)args.in[I_X], (float*)(ws + WS_SSP1), nullptr};
        gemm_phase<E_t, StaticOrder, true, true>(lds, g, S, E); SEAM(4);
    }
    if (IN(5)) {
        Gemm g{(const bf16_t*)(ws + WS_X1), (const bf16_t*)(ws + WS_WQ), 1024, 1024, 1024}; StaticOrder S; S.init(T, 1024, G, bid);
        typedef Epi<2, 0, 0, 0, 0, 0> E_t; E_t E{(void*)(ws + WS_HQ), 1024, (const float*)(ws + WS_SSP1), 0.0625f, nullptr, nullptr, nullptr};
        gemm_phase<E_t, StaticOrder, true, true>(lds, g, S, E); SEAM(5);
    }
    if (IN(6)) {
        Gemm g{(const bf16_t*)(ws + WS_HQ), (const bf16_t*)(ws + WS_KB), 1024, 1024, 256}; AttnOrder<0> S{G, bid};
        typedef Epi<0, 0, 0, 1, 0, 0> E_t; E_t E{(void*)args.out, 1024, nullptr, 1.f, nullptr, nullptr, nullptr};
        gemm_phase<E_t, AttnOrder<0>, true, true>(lds, g, S, E); SEAM(6);
    }
    if (IN(7)) { phase_softmax(args.out, (bf16*)(ws + WS_P), G); SEAM(7); }
    if (IN(8)) {
        Gemm g{(const bf16_t*)(ws + WS_P), (const bf16_t*)(ws + WS_VT), 1024, 4096, 256}; AttnOrder<1> S{G, bid};
        typedef Epi<0, 0, 0, 0, 0, 0> E_t; E_t E{(void*)(ws + WS_ATT), 1024, nullptr, 1.f, nullptr, nullptr, nullptr};
        gemm_phase<E_t, AttnOrder<1>, true, true>(lds, g, S, E); SEAM(8);
    }
    if (IN(9)) {
        Gemm g{(const bf16_t*)(ws + WS_ATT), (const bf16_t*)(ws + WS_WO), 1024, 1024, 1024}; StaticOrder S; S.init(T, 1024, G, bid);
        typedef Epi<0, 0, 2, 0, 1, 0> E_t; E_t E{(void*)(ws + WS_X2), 1024, nullptr, 1.f, (const void*)(ws + WS_X1), (float*)(ws + WS_SSP2), nullptr};
        gemm_phase<E_t, StaticOrder, true, true>(lds, g, S, E); SEAM(9);
    }
    if (IN(10)) {
        Gemm g{(const bf16_t*)(ws + WS_X2), (const bf16_t*)(ws + WS_W1), 1024, 1024, 1024}; StaticOrder S; S.init(T, DFF, G, bid);
        typedef Epi<2, 1, 0, 0, 0, 0> E_t; E_t E{(void*)(ws + WS_HID), DFF, (const float*)(ws + WS_SSP2), 1.f, nullptr, nullptr, nullptr};
        gemm_phase<E_t, StaticOrder, true, true>(lds, g, S, E); SEAM(10);
    }
    if (IN(11)) {
        Gemm g{(const bf16_t*)(ws + WS_HID), (const bf16_t*)(ws + WS_W2), DFF, DFF, DFF}; StaticOrder S; S.init(T, 1024, G, bid);
        typedef Epi<0, 0, 2, 1, 1, 0> E_t; E_t E{(void*)args.out, 1024, nullptr, 1.f, (const void*)(ws + WS_X2), (float*)(ws + WS_SSP3), nullptr};
        gemm_phase<E_t, StaticOrder, true, true>(lds, g, S, E); SEAM(11);
    }
    if (IN(12)) phase_final(args.out, (const float*)(ws + WS_SSP3), args.in[I_FING], G);
#undef IN
#undef SEAM
}

extern "C" void kernel_launch(void* const* d_in, const int* in_sizes, int n_in, void* d_out, int out_size, void* d_ws, size_t ws_size, hipStream_t stream) {
    static int grid = 0;
    if (grid == 0) {
        if (n_in != 23 || in_sizes[0] != T * DM || out_size != T * DM || ws_size < WS_END) { fprintf(stderr, "kernel_launch: unexpected shapes (n_in %d, in0 %d, out %d, ws %zu); nothing launched\n", n_in, n_in > 0 ? in_sizes[0] : -1, out_size, ws_size); grid = -1; return; }
        int dev = 0, cus = 0;
        if (hipGetDevice(&dev) != hipSuccess || hipDeviceGetAttribute(&cus, hipDeviceAttributeMultiprocessorCount, dev) != hipSuccess) { grid = -1; return; }
        if (hipFuncSetAttribute((const void*)fwd_kernel, hipFuncAttributeMaxDynamicSharedMemorySize, LDS_BYTES) != hipSuccess) { fprintf(stderr, "kernel_launch: hipFuncSetAttribute failed\n"); grid = -1; return; }
        int per_cu = 0;
        if (hipOccupancyMaxActiveBlocksPerMultiprocessor(&per_cu, (const void*)fwd_kernel, NWAVES * 64, LDS_BYTES) != hipSuccess || per_cu < 1) fprintf(stderr, "kernel_launch: occupancy query reports %d\n", per_cu);
        (void)hipGetLastError();
        grid = cus;
    }
    if (grid < 0) return;
    (void)hipMemsetAsync((char*)d_ws + WS_CTL, 0, CTL_ZERO_BYTES, stream);
    Args a{};
    for (int i = 0; i < 23; ++i) a.in[i] = (const float*)d_in[i];
    a.out = (float*)d_out; a.ws = (unsigned char*)d_ws;
    if (MK_N_LAUNCHES == 1) { a.ph_lo = 0; a.ph_hi = NPHASES; hipLaunchKernelGGL(fwd_kernel, dim3(grid), dim3(NWAVES * 64), LDS_BYTES, stream, a); }
    else for (int p = 0; p < NPHASES; ++p) { a.ph_lo = p; a.ph_hi = p + 1; hipLaunchKernelGGL(fwd_kernel, dim3(grid), dim3(NWAVES * 64), LDS_BYTES, stream, a); }
}
```

```cpp
#include <hip/hip_runtime.h>
#include <cstdio>
#include <cstdint>
namespace pg8 {
#define PG8_LAS __attribute__((address_space(3)))
typedef unsigned short bf16_t;
typedef short bf16x8 __attribute__((ext_vector_type(8)));
typedef float f32x4 __attribute__((ext_vector_type(4)));
typedef unsigned u32x4 __attribute__((ext_vector_type(4)));
constexpr int BM = 256, BK = 64, HALF = 128, HTB = HALF * BK * 2  , STAGE_BYTES = 8 * HTB, NXCD = 8, WGM = 8;

__host__ __device__ __forceinline__ int lds_byte(int r, int c) { const int st = (r >> 4) * 2 + (c >> 5), rr = r & 15, cc = c & 31, ob = rr * 64 + cc * 2; return st * 1024 + (ob ^ (((ob >> 9) & 1) << 5)); }
__host__ __device__ __forceinline__ void stage_rc(int b, int& R, int& C) { const int st = b / 1024, sb = b % 1024, swz = sb ^ (((sb >> 9) & 1) << 5); R = (st >> 1) * 16 + swz / 64; C = (st & 1) * 32 + (swz % 64) / 2; }
__host__ __device__ __forceinline__ int perm32(int rho) { const int n = rho >> 4, i = rho & 15; return 8 * (i >> 2) + 4 * n + (i & 3); }


struct Unit { int pm, pn; };
struct Gemm { const bf16_t* A; const bf16_t* Bt; int lda, ldb, K; };

struct StaticOrder {
    int nM, nN, nwg, G, c;
    __host__ __device__ void init(int M, int N, int G_, int c_) { nM = M / BM; nN = N / BM; nwg = nM * nN; G = G_; c = c_; }
    __host__ __device__ bool next(int i, Unit& u) const {
        const long L = (long)i * G + c; if (L >= nwg) return false;
        int wgid = (int)L; { const int q = nwg / NXCD, r = nwg % NXCD, xcd = wgid % NXCD, off = wgid / NXCD; wgid = (xcd < r ? xcd * (q + 1) : r * (q + 1) + (xcd - r) * q) + off; }
        const int nig = WGM * nN, gid = wgid / nig, fm = gid * WGM, gsz = (nM - fm) < WGM ? (nM - fm) : WGM;
        u.pm = fm + ((wgid % nig) % gsz); u.pn = (wgid % nig) / gsz; return true;
    }
    __device__ __forceinline__ const char* aptr(const Gemm& g, const Unit& u) const { return (const char*)g.A + (size_t)u.pm * BM * g.lda * 2; }
    __device__ __forceinline__ const char* bptr(const Gemm& g, const Unit& u) const { return (const char*)g.Bt + (size_t)u.pn * BM * g.ldb * 2; }
    __device__ __forceinline__ void a_ready(const Unit&) const {}
    __device__ __forceinline__ void done(const Unit&) const {}
};
template <int MODE> struct AttnOrder {
    int G, c;
    __device__ bool next(int i, Unit& u) const { const long L = (long)i * G + c; if (L >= 1024) return false; u.pm = (int)(L >> 2); u.pn = (int)(L & 3); return true; }
    __device__ __forceinline__ const char* aptr(const Gemm& g, const Unit& u) const { return (const char*)g.A + ((size_t)u.pm * 256 * 1024 + (size_t)u.pn * 256) * 2; }
    __device__ __forceinline__ const char* bptr(const Gemm& g, const Unit& u) const {
        return MODE == 0 ? (const char*)g.Bt + ((size_t)(u.pm >> 4) * 256 * 1024 + (size_t)u.pn * 256) * 2
                         : (const char*)g.Bt + ((size_t)u.pn * 256 * 4096 + (size_t)(u.pm >> 4) * 256) * 2; }
    __device__ __forceinline__ void a_ready(const Unit&) const {}
    __device__ __forceinline__ void done(const Unit&) const {}
};

__device__ __forceinline__ unsigned cvt_pk_bf16(float lo, float hi) { unsigned r; asm volatile("v_cvt_pk_bf16_f32 %0, %1, %2" : "=v"(r) : "v"(lo), "v"(hi)); return r; }
__device__ __forceinline__ float bf_lo(unsigned w) { return __uint_as_float(w << 16); }
__device__ __forceinline__ float bf_hi(unsigned w) { return __uint_as_float(w & 0xffff0000u); }

template <int RS  , int ACT, int RES, int OUTF32, int SSQ, int GATE>
struct Epi {
    static constexpr bool PERM = true, AFTER_DRAIN = false;
    void* out; int ldc; const float* rs; float scale; const void* base; float* ssp; float* gates;
    __device__ __forceinline__ void operator()(const f32x4 (&acc)[2][2][4][2], const Unit& u, int wr, int wc, int fr, int fq) const {
        const int row0 = u.pm * BM + wr * 64 + fr, col0 = u.pn * BM + wc * 32 + 8 * fq;
        const bool gate_tile = GATE && (u.pn == 14);
#pragma unroll
        for (int ai = 0; ai < 2; ++ai)
#pragma unroll
            for (int m = 0; m < 4; ++m) {
                const int r = row0 + ai * HALF + m * 16;
                float rsv = scale;
                if (RS == 1) rsv *= rs[r];
                if (RS == 2) { const f32x4* p = (const f32x4*)(rs + (size_t)r * 16); const f32x4 a = p[0], b = p[1], c = p[2], d = p[3];
                    const float s = ((a[0] + a[1]) + (a[2] + a[3])) + ((b[0] + b[1]) + (b[2] + b[3])) + ((c[0] + c[1]) + (c[2] + c[3])) + ((d[0] + d[1]) + (d[2] + d[3]));
                    rsv *= 1.0f / sqrtf(s * (1.0f / 1024.0f) + 1e-6f); }
                float ss = 0.f;
#pragma unroll
                for (int bj = 0; bj < 2; ++bj) {
                    f32x4 v0 = acc[ai][bj][m][0] * rsv, v1 = acc[ai][bj][m][1] * rsv;
                    if (ACT == 1) { v0 = __builtin_elementwise_max(v0, (f32x4){0.f, 0.f, 0.f, 0.f}); v1 = __builtin_elementwise_max(v1, (f32x4){0.f, 0.f, 0.f, 0.f}); v0 = v0 * v0; v1 = v1 * v1; }
                    const size_t off = (size_t)r * ldc + col0 + bj * HALF;
                    if (RES == 1) { const f32x4* bp = (const f32x4*)((const float*)base + off); v0 = v0 + bp[0]; v1 = v1 + bp[1]; }
                    if (RES == 2) { const u32x4 w = *(const u32x4*)((const bf16_t*)base + off);
                        v0 = v0 + (f32x4){bf_lo(w.x), bf_hi(w.x), bf_lo(w.y), bf_hi(w.y)}; v1 = v1 + (f32x4){bf_lo(w.z), bf_hi(w.z), bf_lo(w.w), bf_hi(w.w)}; }
                    if (SSQ) ss += ((v0[0] * v0[0] + v0[1] * v0[1]) + (v0[2] * v0[2] + v0[3] * v0[3])) + ((v1[0] * v1[0] + v1[1] * v1[1]) + (v1[2] * v1[2] + v1[3] * v1[3]));
                    if (gate_tile) { if (bj == 0 && wc == 0 && fq < 3) { f32x4* gp = (f32x4*)(gates + (size_t)r * 32 + 8 * fq); gp[0] = v0; gp[1] = v1; } }
                    else if (OUTF32) { f32x4* op = (f32x4*)((float*)out + off); op[0] = v0; op[1] = v1; }
                    else { u32x4 w; w.x = cvt_pk_bf16(v0[0], v0[1]); w.y = cvt_pk_bf16(v0[2], v0[3]); w.z = cvt_pk_bf16(v1[0], v1[1]); w.w = cvt_pk_bf16(v1[2], v1[3]);
                        *(u32x4*)((bf16_t*)out + off) = w; }
                }
                if (SSQ) { ss += __shfl_xor(ss, 16); ss += __shfl_xor(ss, 32); if (fq == 0) ssp[(size_t)r * 16 + u.pn * 4 + wc] = ss; }
                if (RS == 2 || RES != 0) asm volatile("" ::: "memory");
            }
    }
};

template <class Epi, class Sched, bool ALIGN_EPI = false, bool SP2 = false>
__device__ __forceinline__ void gemm_phase(PG8_LAS unsigned char* lds, const Gemm g, const Sched& S, const Epi& E) {
    const int tid = threadIdx.x, wid = __builtin_amdgcn_readfirstlane(tid >> 6), lane = tid & 63, wr = wid >> 2, wc = wid & 3, fr = lane & 15, fq = lane >> 4;
    const int K = g.K, nt = K / BK;
    unsigned voffA[2], voffB[2];
#pragma unroll
    for (int i = 0; i < 2; ++i) { int R, C; stage_rc(tid * 16 + i * 8192, R, C); const int Rb = Epi::PERM ? ((R & ~31) + perm32(R & 31)) : R;
        voffA[i] = (unsigned)(R * g.lda + C) * 2u; voffB[i] = (unsigned)(Rb * g.ldb + C) * 2u; }
    const size_t kstep = (size_t)(BK * 2);
    const size_t hstepA = (size_t)HALF * g.lda * 2, hstepB = (size_t)HALF * g.ldb * 2;
    const unsigned ldsw = (unsigned)wid * 1024u;
    const int aoff = lds_byte(wr * 64 + fr, fq * 8), boff = lds_byte(wc * 32 + fr, fq * 8);
#define PG8_SA(b, h) (((b) * 2 + (h)) * HTB)
#define PG8_SB(b, h) ((4 + (b) * 2 + (h)) * HTB)
#define PG8_STAGE(bufoff, gbase, voff) do { _Pragma("unroll") for (int _i = 0; _i < 2; ++_i) \
        __builtin_amdgcn_global_load_lds((const unsigned*)((const char*)(gbase) + (voff)[_i]), (PG8_LAS unsigned*)(lds + (bufoff) + ldsw + _i * 8192), 16, 0, 0); } while (0)
#define PG8_LDA(dst, b, h) do { _Pragma("unroll") for (int m = 0; m < 4; ++m) _Pragma("unroll") for (int k = 0; k < 2; ++k) dst[m][k] = *(const PG8_LAS bf16x8*)(lds + PG8_SA(b, h) + aoff + m * 2048 + k * 1024); } while (0)
#define PG8_LDB(dst, b, h) do { _Pragma("unroll") for (int n = 0; n < 2; ++n) _Pragma("unroll") for (int k = 0; k < 2; ++k) dst[n][k] = *(const PG8_LAS bf16x8*)(lds + PG8_SB(b, h) + boff + n * 2048 + k * 1024); } while (0)
#define PG8_MMA(ai, bj, At, Bt) do { __builtin_amdgcn_s_setprio(1); _Pragma("unroll") for (int m = 0; m < 4; ++m) _Pragma("unroll") for (int n = 0; n < 2; ++n) _Pragma("unroll") for (int k = 0; k < 2; ++k) \
        acc[ai][bj][m][n] = __builtin_amdgcn_mfma_f32_16x16x32_bf16(Bt[n][k], At[m][k], acc[ai][bj][m][n], 0, 0, 0); __builtin_amdgcn_s_setprio(0); } while (0)
#define PG8_WAIT_V(n) asm volatile("s_waitcnt vmcnt(" #n ")" ::: "memory")
#define PG8_WAIT_L(n) asm volatile("s_waitcnt lgkmcnt(" #n ")" ::: "memory")
#define PG8_BAR __builtin_amdgcn_s_barrier()
#define PG8_SCHED __builtin_amdgcn_sched_barrier(0)
    Unit cur, nxt; int ui = 0;
    if (!S.next(0, cur)) return;
    f32x4 acc[2][2][4][2];
#pragma unroll
    for (int a = 0; a < 2; ++a)
#pragma unroll
        for (int b = 0; b < 2; ++b)
#pragma unroll
            for (int m = 0; m < 4; ++m)
#pragma unroll
                for (int n = 0; n < 2; ++n) acc[a][b][m][n] = (f32x4){0.f, 0.f, 0.f, 0.f};
    bf16x8 At[4][2], B0[2][2], B1[2][2];
    const char* cA = S.aptr(g, cur); const char* cB = S.bptr(g, cur);
    S.a_ready(cur);
    if constexpr (SP2) {
        PG8_STAGE(PG8_SB(0, 0), cB, voffB); PG8_STAGE(PG8_SB(0, 1), cB + hstepB, voffB); PG8_STAGE(PG8_SA(0, 0), cA, voffA); PG8_STAGE(PG8_SA(0, 1), cA + hstepA, voffA);
        if (wr == 1) PG8_BAR;
        PG8_WAIT_V(2); PG8_BAR;
        PG8_STAGE(PG8_SB(1, 0), cB + kstep, voffB); PG8_STAGE(PG8_SA(1, 0), cA + kstep, voffA); PG8_STAGE(PG8_SB(1, 1), cB + hstepB + kstep, voffB);
        PG8_WAIT_V(6); PG8_BAR;
    } else {
        PG8_STAGE(PG8_SB(0, 0), cB, voffB); PG8_STAGE(PG8_SA(0, 0), cA, voffA); PG8_STAGE(PG8_SB(0, 1), cB + hstepB, voffB); PG8_STAGE(PG8_SA(0, 1), cA + hstepA, voffA);
        if (wr == 1) PG8_BAR;
        PG8_WAIT_V(4); PG8_BAR;
        PG8_STAGE(PG8_SB(1, 0), cB + kstep, voffB); PG8_STAGE(PG8_SA(1, 0), cA + kstep, voffA); PG8_STAGE(PG8_SB(1, 1), cB + hstepB + kstep, voffB);
        PG8_WAIT_V(6); PG8_BAR;
    }
    for (;;) {
        const bool has_next = S.next(ui + 1, nxt);
        const char* nA = has_next ? S.aptr(g, nxt) : cA; const char* nB = has_next ? S.bptr(g, nxt) : cB;
        _Pragma("unroll 1") for (int t = 0; t < nt; t += 2) {
            const bool last = (t == nt - 2);
            const char* a1 = cA + (size_t)(t + 1) * kstep;
            const char* a2 = last ? nA : cA + (size_t)(t + 2) * kstep; const char* b2 = last ? nB : cB + (size_t)(t + 2) * kstep;
            const char* a3 = a2 + kstep; const char* b3 = b2 + kstep;
            if (last && has_next) S.a_ready(nxt);
            if constexpr (SP2) {
            PG8_LDB(B0, 0, 0); PG8_LDB(B1, 0, 1); PG8_SCHED; PG8_LDA(At, 0, 0); PG8_STAGE(PG8_SA(1, 1), a1 + hstepA, voffA);
            PG8_WAIT_V(8); PG8_WAIT_L(0); PG8_BAR; PG8_MMA(0, 0, At, B0); PG8_MMA(0, 1, At, B1); PG8_BAR; PG8_SCHED;
            PG8_LDA(At, 0, 1); PG8_STAGE(PG8_SB(0, 0), b2, voffB); PG8_STAGE(PG8_SB(0, 1), b2 + hstepB, voffB); PG8_STAGE(PG8_SA(0, 0), a2, voffA);
            PG8_WAIT_V(8); PG8_WAIT_L(0); PG8_BAR; PG8_MMA(1, 0, At, B0); PG8_MMA(1, 1, At, B1); PG8_BAR; PG8_SCHED;
            PG8_LDB(B0, 1, 0); PG8_LDB(B1, 1, 1); PG8_SCHED; PG8_LDA(At, 1, 0); PG8_STAGE(PG8_SA(0, 1), a2 + hstepA, voffA);
            PG8_WAIT_V(8); PG8_WAIT_L(0); PG8_BAR; PG8_MMA(0, 0, At, B0); PG8_MMA(0, 1, At, B1); PG8_BAR; PG8_SCHED;
            PG8_LDA(At, 1, 1); PG8_STAGE(PG8_SB(1, 0), b3, voffB); PG8_STAGE(PG8_SB(1, 1), b3 + hstepB, voffB); PG8_STAGE(PG8_SA(1, 0), a3, voffA);
            PG8_WAIT_V(8); PG8_WAIT_L(0); PG8_BAR; PG8_MMA(1, 0, At, B0); PG8_MMA(1, 1, At, B1); PG8_BAR; PG8_SCHED;
            } else {
            PG8_LDB(B0, 0, 0); PG8_SCHED; PG8_LDA(At, 0, 0); PG8_STAGE(PG8_SA(1, 1), a1 + hstepA, voffA);
            PG8_WAIT_L(8); PG8_BAR; PG8_WAIT_L(0); PG8_MMA(0, 0, At, B0); PG8_BAR; PG8_SCHED;
            PG8_LDB(B1, 0, 1); PG8_STAGE(PG8_SB(0, 0), b2, voffB);
            PG8_BAR; PG8_WAIT_L(0); PG8_MMA(0, 1, At, B1); PG8_BAR;
            PG8_LDA(At, 0, 1); PG8_STAGE(PG8_SA(0, 0), a2, voffA);
            PG8_BAR; PG8_WAIT_L(0); PG8_MMA(1, 0, At, B0); PG8_BAR; PG8_SCHED;
            PG8_STAGE(PG8_SB(0, 1), b2 + hstepB, voffB);
            PG8_WAIT_V(6); PG8_BAR; PG8_MMA(1, 1, At, B1); PG8_BAR;
            PG8_LDB(B0, 1, 0); PG8_SCHED; PG8_LDA(At, 1, 0); PG8_STAGE(PG8_SA(0, 1), a2 + hstepA, voffA);
            PG8_WAIT_L(8); PG8_BAR; PG8_WAIT_L(0); PG8_MMA(0, 0, At, B0); PG8_BAR; PG8_SCHED;
            PG8_LDB(B1, 1, 1); PG8_STAGE(PG8_SB(1, 0), b3, voffB);
            PG8_BAR; PG8_WAIT_L(0); PG8_MMA(0, 1, At, B1); PG8_BAR;
            PG8_LDA(At, 1, 1); PG8_STAGE(PG8_SA(1, 0), a3, voffA);
            PG8_BAR; PG8_WAIT_L(0); PG8_MMA(1, 0, At, B0); PG8_BAR; PG8_SCHED;
            PG8_STAGE(PG8_SB(1, 1), b3 + hstepB, voffB);
            PG8_WAIT_V(6); PG8_BAR; PG8_MMA(1, 1, At, B1); PG8_BAR;
            }
        }
        if constexpr (ALIGN_EPI) { if (wr == 0) PG8_BAR; }
        if constexpr (!Epi::AFTER_DRAIN) { E(acc, cur, wr, wc, fr, fq); S.done(cur); }
        if (!has_next) break;
#pragma unroll
        for (int a = 0; a < 2; ++a)
#pragma unroll
            for (int b = 0; b < 2; ++b)
#pragma unroll
                for (int m = 0; m < 4; ++m)
#pragma unroll
                    for (int n = 0; n < 2; ++n) acc[a][b][m][n] = (f32x4){0.f, 0.f, 0.f, 0.f};
        cur = nxt; cA = nA; cB = nB; ++ui;
        if constexpr (ALIGN_EPI) { if (wr == 1) PG8_BAR; }
    }
    PG8_WAIT_V(0);
    if constexpr (!ALIGN_EPI) { if (wr == 0) PG8_BAR; }
    PG8_BAR;
    if constexpr (Epi::AFTER_DRAIN) { E.fused(acc, cur, wr, wc, fr, fq, lds, wid, lane); S.done(cur); }
#undef PG8_SA
#undef PG8_SB
#undef PG8_STAGE
#undef PG8_LDA
#undef PG8_LDB
#undef PG8_MMA
#undef PG8_WAIT_V
#undef PG8_WAIT_L
#undef PG8_BAR
#undef PG8_SCHED
}
}

constexpr int NWAVES = 8;
constexpr int BATCH = 16, SEQ = 4096, DM = 1024, T = BATCH * SEQ, MEML = 256, TMEM = BATCH * MEML, DFF = 4096, NU = 3584, NINP = 3840;
constexpr float EPS = 1e-6f;
constexpr size_t MiB = 1u << 20;
constexpr size_t WS_CTL = 0, CTL_ZERO_BYTES = 1 * MiB;
constexpr size_t WS_WIN = 2 * MiB, WS_WOUT = 10 * MiB, WS_WQ = 12 * MiB, WS_WK = 14 * MiB, WS_WV = 16 * MiB, WS_WO = 18 * MiB, WS_W1 = 20 * MiB, WS_W2 = 28 * MiB;
constexpr size_t WS_MEMN = 36 * MiB, WS_KB = 44 * MiB, WS_VT = 52 * MiB, WS_RSTD0 = 60 * MiB, WS_SSP1 = 61 * MiB, WS_SSP2 = 65 * MiB, WS_SSP3 = 69 * MiB;
constexpr size_t WS_GATES = 73 * MiB, WS_LI = 81 * MiB, WS_BF = 82 * MiB, WS_EBL = 83 * MiB;
constexpr size_t WS_XB = 96 * MiB, WS_X1 = 96 * MiB, WS_U = 224 * MiB, WS_QM = 672 * MiB, WS_KM = 736 * MiB, WS_QG = 800 * MiB, WS_KG = 832 * MiB, WS_KW = 864 * MiB;
constexpr size_t WS_HM = 896 * MiB, WS_X2 = 896 * MiB, WS_HQ = 224 * MiB, WS_P = 352 * MiB, WS_ATT = 480 * MiB, WS_HID = 224 * MiB, WS_END = 1024 * MiB;
constexpr int CW_BAR = 4096;
constexpr int LDS_BYTES = 163840, MISC_OFF = LDS_BYTES - 512;

#define LAS __attribute__((address_space(3)))
typedef unsigned short bf16;
typedef unsigned v4u __attribute__((ext_vector_type(4)));
typedef unsigned v2u __attribute__((ext_vector_type(2)));
typedef float f32x4 __attribute__((ext_vector_type(4)));
#define LDS_WAIT() asm volatile("s_waitcnt lgkmcnt(0)" ::: "memory")
__device__ __forceinline__ unsigned f2bf(float f) { unsigned u = __builtin_bit_cast(unsigned, f); return (u + 0x7fffu + ((u >> 16) & 1u)) >> 16; }
__device__ __forceinline__ unsigned pk2(float lo, float hi) { return f2bf(lo) | (f2bf(hi) << 16); }
__device__ __forceinline__ float bf2f(bf16 v) { return __uint_as_float((unsigned)v << 16); }
__device__ __forceinline__ float wave_sum(float v) {
#pragma unroll
    for (int o = 1; o < 64; o <<= 1) v += __shfl_xor(v, o);
    return v;
}
__device__ __forceinline__ float wave_max(float v) {
#pragma unroll
    for (int o = 1; o < 64; o <<= 1) v = fmaxf(v, __shfl_xor(v, o));
    return v;
}
__device__ __forceinline__ float logsig(float x) { return fminf(x, 0.f) - log1pf(expf(-fabsf(x))); }

#define XB_TMO      128
#define XB_XCNT(j)  (256  + 64 * (j))
#define XB_XSUB(j)  (1280 + 64 * (j))
#define XB_XGEN(j)  (2304 + 64 * (j))
#define XB_TOP      3328
#define XB_TOPGEN   3392
#define XCD_BAR_WORDS 3456
#define XB_SPIN_CAP (1u << 18)

__device__ __forceinline__ unsigned xb_ld(unsigned* p)              { return __hip_atomic_load(p, __ATOMIC_RELAXED, __HIP_MEMORY_SCOPE_AGENT); }
__device__ __forceinline__ unsigned xb_add(unsigned* p, unsigned v) { return __hip_atomic_fetch_add(p, v, __ATOMIC_RELAXED, __HIP_MEMORY_SCOPE_AGENT); }
__device__ __forceinline__ unsigned xb_xcc_id() { return (unsigned)__builtin_amdgcn_s_getreg((3 << 11) | 20) & 0xFu; }
#define XB_SPIN(cond, bar) do { unsigned _sp = 0; while (cond) { __builtin_amdgcn_s_sleep(1); \
    if ((++_sp & 255u) == 0u) { if (xb_ld(&(bar)[XB_TMO])) break; if (_sp > XB_SPIN_CAP) { atomicAdd(&(bar)[XB_TMO], 1u); break; } } } } while (0)

struct XcdBarrier {
    unsigned* bar; unsigned x;
    volatile LAS unsigned* st;
};

__device__ __forceinline__ XcdBarrier xcd_barrier_post(unsigned* bar, volatile LAS unsigned* st) {
    XcdBarrier b; b.bar = bar; b.x = xb_xcc_id(); b.st = st;
    if (threadIdx.x == 0) (void)xb_add(&bar[XB_XCNT(b.x)], 1u);
    return b;
}
__device__ __forceinline__ void xcd_barrier_complete(unsigned* bar, unsigned x, unsigned& nloc, unsigned& nx) {
    const unsigned G = gridDim.x * gridDim.y * gridDim.z;
    unsigned sum, cnt, mine, sp = 0u;
    for (;;) {
        sum = 0u; cnt = 0u; mine = 0u;
#pragma unroll
        for (unsigned j = 0; j < 16; ++j) { const unsigned c = xb_ld(&bar[XB_XCNT(j)]); sum += c; cnt += (c > 0u) ? 1u : 0u; mine = (j == x) ? c : mine; }
        if (sum == G) break;
        __builtin_amdgcn_s_sleep(1);
        if ((++sp & 255u) == 0u) { if (xb_ld(&bar[XB_TMO])) break; if (sp > XB_SPIN_CAP) { atomicAdd(&bar[XB_TMO], 1u); break; } }
    }
    nloc = mine > 0u ? mine : 1u; nx = cnt > 0u ? cnt : 1u;
}

__device__ __forceinline__ void xcd_barrier(const XcdBarrier& b) {
    asm volatile("s_waitcnt vmcnt(0)" ::: "memory");
    __syncthreads();
    if (threadIdx.x == 0) {
        unsigned* bar = b.bar;
        __builtin_amdgcn_s_waitcnt(0);
        unsigned nloc = b.st[0], nx = b.st[1];
        if (nloc == 0u) { xcd_barrier_complete(bar, b.x, nloc, nx); b.st[0] = nloc; b.st[1] = nx; }
        const unsigned old = xb_add(&bar[XB_XSUB(b.x)], 1u);
        const unsigned gen = old / nloc;
        if (old + 1u == (gen + 1u) * nloc) {
            __builtin_amdgcn_fence(__ATOMIC_RELEASE, "agent");
            asm volatile("s_waitcnt vmcnt(0)" ::: "memory");
            const unsigned og = xb_add(&bar[XB_TOP], 1u);
            const unsigned tg = og / nx;
            if (og + 1u == (tg + 1u) * nx) xb_add(&bar[XB_TOPGEN], 1u);
            else XB_SPIN(xb_ld(&bar[XB_TOPGEN]) == tg, bar);
            __builtin_amdgcn_fence(__ATOMIC_ACQUIRE, "agent");
            xb_add(&bar[XB_XGEN(b.x)], 1u);
            asm volatile("s_waitcnt vmcnt(0)" ::: "memory");
        } else {
            XB_SPIN(xb_ld(&bar[XB_XGEN(b.x)]) == gen, bar);
            __builtin_amdgcn_fence(__ATOMIC_ACQUIRE, "agent");
            asm volatile("s_waitcnt vmcnt(0)" ::: "memory");
        }
    }
    __syncthreads();
}

struct Args { const float* in[23]; float* out; unsigned char* ws; int ph_lo, ph_hi; };
enum { I_X = 0, I_MEM, I_MIXG, I_WIN, I_CONVW, I_CONVB, I_IB, I_FB, I_MNG, I_WA2, I_BA, I_GNG, I_WOUT, I_XAG, I_MEMG, I_WQ, I_WK, I_WV, I_WO, I_MLPG, I_W1, I_W2, I_FING };

__device__ __forceinline__ int map_col(int mode, int nd) {
    if (mode == 0) return nd;
    if (nd < 2048) return nd; if (nd < 3584) return nd + 8; if (nd < 3592) return nd - 3584 + 2048; if (nd < 3608) return nd; return -1;
}
__device__ __forceinline__ void p0_transpose_item(const float* W, int K, int N, const float* gain, bf16* WT, int ndst_blk, int mode, LAS float* scr, int item, int lane) {
    const int kb = item / ndst_blk, nb = item % ndst_blk, k0 = 64 * kb, n0 = 32 * nb;
    const int ns = map_col(mode, n0 + (lane & 31));
#pragma unroll 8
    for (int i = 0; i < 32; ++i) { const int kk = 2 * i + (lane >> 5); float v = 0.f; if (ns >= 0) { v = W[(size_t)(k0 + kk) * N + ns]; if (gain) v *= gain[k0 + kk]; } scr[kk * 33 + (lane & 31)] = v; }
    LDS_WAIT(); asm volatile("" ::: "memory");
    const int c = lane & 7;
#pragma unroll
    for (int j = 0; j < 4; ++j) { const int n = (lane >> 3) + 8 * j; const LAS float* s = scr + (8 * c) * 33 + n;
        v4u o; o.x = pk2(s[0 * 33], s[1 * 33]); o.y = pk2(s[2 * 33], s[3 * 33]); o.z = pk2(s[4 * 33], s[5 * 33]); o.w = pk2(s[6 * 33], s[7 * 33]);
        *(v4u*)(WT + (size_t)(n0 + n) * K + k0 + 8 * c) = o; }
    LDS_WAIT(); asm volatile("" ::: "memory");
}

__device__ __forceinline__ void phase_prologue(const Args& a, LAS unsigned char* lds, int G) {
    const int tid = threadIdx.x, lane = tid & 63, wave = tid >> 6;
    unsigned char* ws = a.ws;
    LAS float* scr = (LAS float*)(lds + wave * 16384);
    const int gw = blockIdx.x * NWAVES + wave, NGW = G * NWAVES;
    constexpr int I_IN = 16 * 120, I_SQ = 16 * 32, I_1 = 16 * 128, I_2 = 64 * 32;
    constexpr int NITEMS = I_IN + 5 * I_SQ + I_1 + I_2;
    for (int it = gw; it < NITEMS; it += NGW) {
        int r = it;
        if (r < I_IN) { p0_transpose_item(a.in[I_WIN], 1024, 3608, a.in[I_MIXG], (bf16*)(ws + WS_WIN), 120, 1, scr, r, lane); continue; } r -= I_IN;
        if (r < I_SQ) { p0_transpose_item(a.in[I_WOUT], 1024, 1024, nullptr, (bf16*)(ws + WS_WOUT), 32, 0, scr, r, lane); continue; } r -= I_SQ;
        if (r < I_SQ) { p0_transpose_item(a.in[I_WQ], 1024, 1024, a.in[I_XAG], (bf16*)(ws + WS_WQ), 32, 0, scr, r, lane); continue; } r -= I_SQ;
        if (r < I_SQ) { p0_transpose_item(a.in[I_WK], 1024, 1024, a.in[I_MEMG], (bf16*)(ws + WS_WK), 32, 0, scr, r, lane); continue; } r -= I_SQ;
        if (r < I_SQ) { p0_transpose_item(a.in[I_WV], 1024, 1024, a.in[I_MEMG], (bf16*)(ws + WS_WV), 32, 0, scr, r, lane); continue; } r -= I_SQ;
        if (r < I_SQ) { p0_transpose_item(a.in[I_WO], 1024, 1024, nullptr, (bf16*)(ws + WS_WO), 32, 0, scr, r, lane); continue; } r -= I_SQ;
        if (r < I_1) { p0_transpose_item(a.in[I_W1], 1024, 4096, a.in[I_MLPG], (bf16*)(ws + WS_W1), 128, 0, scr, r, lane); continue; } r -= I_1;
        p0_transpose_item(a.in[I_W2], 4096, 1024, nullptr, (bf16*)(ws + WS_W2), 32, 0, scr, r, lane);
    }
    const float* x = a.in[I_X]; bf16* XB = (bf16*)(ws + WS_XB); float* rstd0 = (float*)(ws + WS_RSTD0);
    for (int m = gw; m < T; m += NGW) {
        const f32x4* xr = (const f32x4*)(x + (size_t)m * DM) + lane; f32x4 v[4]; float s = 0.f;
#pragma unroll
        for (int j = 0; j < 4; ++j) { v[j] = xr[64 * j]; s += (v[j].x * v[j].x + v[j].y * v[j].y) + (v[j].z * v[j].z + v[j].w * v[j].w); }
        s = wave_sum(s);
        if (lane == 0) rstd0[m] = 1.0f / sqrtf(s * (1.0f / DM) + EPS);
        v2u* o8 = (v2u*)(XB + (size_t)m * DM) + lane;
#pragma unroll
        for (int j = 0; j < 4; ++j) o8[64 * j] = (v2u){pk2(v[j].x, v[j].y), pk2(v[j].z, v[j].w)};
    }
    const float* mem = a.in[I_MEM]; bf16* MEMN = (bf16*)(ws + WS_MEMN);
    for (int m = gw; m < TMEM; m += NGW) {
        const f32x4* xr = (const f32x4*)(mem + (size_t)m * DM) + lane; f32x4 v[4]; float s = 0.f;
#pragma unroll
        for (int j = 0; j < 4; ++j) { v[j] = xr[64 * j]; s += (v[j].x * v[j].x + v[j].y * v[j].y) + (v[j].z * v[j].z + v[j].w * v[j].w); }
        s = wave_sum(s);
        const float rs = 1.0f / sqrtf(s * (1.0f / DM) + EPS);
        v2u* o8 = (v2u*)(MEMN + (size_t)m * DM) + lane;
#pragma unroll
        for (int j = 0; j < 4; ++j) o8[64 * j] = (v2u){pk2(v[j].x * rs, v[j].y * rs), pk2(v[j].z * rs, v[j].w * rs)};
    }
}

__device__ __forceinline__ void phase_prep(const Args& a, LAS unsigned char* lds, int G) {
    const int tid = threadIdx.x;
    unsigned char* ws = a.ws;
    const bf16* U = (const bf16*)(ws + WS_U); const float* gates = (const float*)(ws + WS_GATES);
    bf16* QM = (bf16*)(ws + WS_QM); bf16* KM = (bf16*)(ws + WS_KM); bf16* QG = (bf16*)(ws + WS_QG); bf16* KG = (bf16*)(ws + WS_KG); bf16* KW = (bf16*)(ws + WS_KW);
    float* LI = (float*)(ws + WS_LI); float* BF = (float*)(ws + WS_BF); float* EBL = (float*)(ws + WS_EBL);
    LAS float* gl = (LAS float*)lds;
    LAS float* BL = gl + 64 * 32;
    for (int ci = blockIdx.x; ci < T / 64; ci += G) {
        const size_t t0 = (size_t)ci * 64; const bool first = (ci & 63) == 0;
        ((LAS f32x4*)gl)[tid] = ((const f32x4*)(gates + t0 * 32))[tid];
        __syncthreads();
        {
            const int cg = tid & 127, tg = tid >> 7, c0 = cg * 8, tl0 = tg * 16;
            const float* cw = a.in[I_CONVW]; const float* cb = a.in[I_CONVB];
            float w0[8], w1[8], w2[8], w3[8], bb[8], xm3[8], xm2[8], xm1[8];
#pragma unroll
            for (int i = 0; i < 8; ++i) { w0[i] = cw[c0 + i]; w1[i] = cw[1024 + c0 + i]; w2[i] = cw[2048 + c0 + i]; w3[i] = cw[3072 + c0 + i]; bb[i] = cb[c0 + i]; }
            {
                v4u r3 = {0, 0, 0, 0}, r2 = {0, 0, 0, 0}, r1 = {0, 0, 0, 0};
                if (tl0 > 0 || !first) { r3 = *(const v4u*)(U + (t0 + tl0 - 3) * NU + c0); r2 = *(const v4u*)(U + (t0 + tl0 - 2) * NU + c0); r1 = *(const v4u*)(U + (t0 + tl0 - 1) * NU + c0); }
                xm3[0] = pg8::bf_lo(r3.x); xm3[1] = pg8::bf_hi(r3.x); xm3[2] = pg8::bf_lo(r3.y); xm3[3] = pg8::bf_hi(r3.y); xm3[4] = pg8::bf_lo(r3.z); xm3[5] = pg8::bf_hi(r3.z); xm3[6] = pg8::bf_lo(r3.w); xm3[7] = pg8::bf_hi(r3.w);
                xm2[0] = pg8::bf_lo(r2.x); xm2[1] = pg8::bf_hi(r2.x); xm2[2] = pg8::bf_lo(r2.y); xm2[3] = pg8::bf_hi(r2.y); xm2[4] = pg8::bf_lo(r2.z); xm2[5] = pg8::bf_hi(r2.z); xm2[6] = pg8::bf_lo(r2.w); xm2[7] = pg8::bf_hi(r2.w);
                xm1[0] = pg8::bf_lo(r1.x); xm1[1] = pg8::bf_hi(r1.x); xm1[2] = pg8::bf_lo(r1.y); xm1[3] = pg8::bf_hi(r1.y); xm1[4] = pg8::bf_lo(r1.z); xm1[5] = pg8::bf_hi(r1.z); xm1[6] = pg8::bf_lo(r1.w); xm1[7] = pg8::bf_hi(r1.w);
            }
            const float qs = (c0 < 512) ? 0.08838834764831845f : 1.0f;
            bf16* dst = (c0 < 512) ? (QM + c0) : (KM + (c0 - 512));
            for (int tt = 0; tt < 16; ++tt) {
                const size_t t = t0 + tl0 + tt;
                const v4u rc = *(const v4u*)(U + t * NU + c0);
                float xc[8] = {pg8::bf_lo(rc.x), pg8::bf_hi(rc.x), pg8::bf_lo(rc.y), pg8::bf_hi(rc.y), pg8::bf_lo(rc.z), pg8::bf_hi(rc.z), pg8::bf_lo(rc.w), pg8::bf_hi(rc.w)};
                float y[8];
#pragma unroll
                for (int i = 0; i < 8; ++i) { const float v = bb[i] + w0[i] * xm3[i] + w1[i] * xm2[i] + w2[i] * xm1[i] + w3[i] * xc[i]; y[i] = qs * v / (1.0f + expf(-v)); xm3[i] = xm2[i]; xm2[i] = xm1[i]; xm1[i] = xc[i]; }
                *(v4u*)(dst + t * 512) = (v4u){pk2(y[0], y[1]), pk2(y[2], y[3]), pk2(y[4], y[5]), pk2(y[6], y[7])};
            }
        }
        if (tid < 4) {
            const int h = tid; const float ib = a.in[I_IB][h], fb = a.in[I_FB][h]; float run = 0.f;
            for (int t = 0; t < 64; ++t) { const float li = gl[t * 32 + h] + ib; run += logsig(gl[t * 32 + 4 + h] + fb); LI[(t0 + t) * 4 + h] = li; BF[(t0 + t) * 4 + h] = run; }
        }
        if (tid >= 256) {
            const int c = tid - 256; const float* wa2 = a.in[I_WA2]; float w[16];
#pragma unroll
            for (int r = 0; r < 16; ++r) w[r] = wa2[r * 256 + c];
            const float ba = a.in[I_BA][c]; float run = 0.f;
            for (int t = 0; t < 64; ++t) { float xa = ba;
#pragma unroll
                for (int r = 0; r < 16; ++r) xa += gl[t * 32 + 8 + r] * w[r];
                run += logsig(xa) * (1.0f / 16.0f); BL[t * 256 + c] = run; }
        }
        __syncthreads();
        {
            const int c8 = (tid & 31) * 8;
#pragma unroll
            for (int i = 0; i < 4; ++i) { const int t = (tid >> 5) + 16 * i;
                const v4u rq = *(const v4u*)(U + (t0 + t) * NU + 2048 + c8), rk = *(const v4u*)(U + (t0 + t) * NU + 2304 + c8);
                const float q[8] = {pg8::bf_lo(rq.x), pg8::bf_hi(rq.x), pg8::bf_lo(rq.y), pg8::bf_hi(rq.y), pg8::bf_lo(rq.z), pg8::bf_hi(rq.z), pg8::bf_lo(rq.w), pg8::bf_hi(rq.w)};
                const float k[8] = {pg8::bf_lo(rk.x), pg8::bf_hi(rk.x), pg8::bf_lo(rk.y), pg8::bf_hi(rk.y), pg8::bf_lo(rk.z), pg8::bf_hi(rk.z), pg8::bf_lo(rk.w), pg8::bf_hi(rk.w)};
                float oq[8], ok[8], ow[8];
#pragma unroll
                for (int j = 0; j < 8; ++j) { const float b = BL[t * 256 + c8 + j], bL = BL[63 * 256 + c8 + j]; oq[j] = q[j] * 0.125f * expf(b); ok[j] = k[j] * expf(-b); ow[j] = k[j] * expf(bL - b); }
                *(v4u*)(QG + (t0 + t) * 256 + c8) = (v4u){pk2(oq[0], oq[1]), pk2(oq[2], oq[3]), pk2(oq[4], oq[5]), pk2(oq[6], oq[7])};
                *(v4u*)(KG + (t0 + t) * 256 + c8) = (v4u){pk2(ok[0], ok[1]), pk2(ok[2], ok[3]), pk2(ok[4], ok[5]), pk2(ok[6], ok[7])};
                *(v4u*)(KW + (t0 + t) * 256 + c8) = (v4u){pk2(ow[0], ow[1]), pk2(ow[2], ow[3]), pk2(ow[4], ow[5]), pk2(ow[6], ow[7])};
            }
            if (tid < 256) EBL[(size_t)ci * 256 + tid] = expf(BL[63 * 256 + tid]);
        }
        __syncthreads();
    }
}

__device__ __forceinline__ void mlstm_scalar(LAS unsigned char* lds, int b, int h, const bf16* QM, const bf16* KM, const bf16* U, const float* LI, const float* BF, const float* gnorm, bf16* HM) {
    const int tid = threadIdx.x;
    LAS bf16* qs = (LAS bf16*)lds;
    LAS bf16* ks = qs + 64 * 136;
    LAS bf16* vs = ks + 64 * 136;
    LAS float* Ss = (LAS float*)(lds + 52224);
    LAS float* Cs = (LAS float*)(lds + 68864);
    LAS float* ns = (LAS float*)(lds + 134400);
    LAS float* bs = ns + 128; LAS float* lis = bs + 64; LAS float* wint = lis + 64; LAS float* dinv = wint + 64; LAS float* wgs = dinv + 64;
    LAS float* hs = (LAS float*)lds;
    for (int i = tid; i < 128 * 128; i += 512) Cs[i] = 0.f;
    if (tid < 128) ns[tid] = 0.f;
    float m = 0.f;
    __syncthreads();
    for (int c = 0; c < 64; ++c) {
        const size_t t0 = (size_t)b * SEQ + (size_t)c * 64;
        for (int i = tid; i < 1024; i += 512) { const int t = i >> 4, cc = i & 15;
            *(LAS v4u*)(qs + t * 136 + cc * 8) = *(const v4u*)(QM + (t0 + t) * 512 + h * 128 + cc * 8);
            *(LAS v4u*)(ks + t * 136 + cc * 8) = *(const v4u*)(KM + (t0 + t) * 512 + h * 128 + cc * 8);
            *(LAS v4u*)(vs + t * 136 + cc * 8) = *(const v4u*)(U + (t0 + t) * NU + 1024 + h * 128 + cc * 8); }
        if (tid < 64) { bs[tid] = BF[(t0 + tid) * 4 + h]; lis[tid] = LI[(t0 + tid) * 4 + h]; }
        __syncthreads();
        { const int t = tid >> 3, sg = tid & 7;
            for (int i = 0; i < 8; ++i) { const int s = sg + 8 * i; if (s <= t) { float acc = 0.f; _Pragma("unroll 1") for (int d = 0; d < 128; ++d) acc += bf2f(qs[t * 136 + d]) * bf2f(ks[s * 136 + d]); Ss[t * 65 + s] = acc; } } }
        __syncthreads();
        if (tid < 64) { const int t = tid; const float bt = bs[t]; float mloc = bt + m;
            _Pragma("unroll 1") for (int s = 0; s <= t; ++s) mloc = fmaxf(mloc, bt - bs[s] + lis[s]);
            float rowsum = 0.f;
            _Pragma("unroll 1") for (int s = 0; s <= t; ++s) { const float v = Ss[t * 65 + s] * expf(bt - bs[s] + lis[s] - mloc); Ss[t * 65 + s] = v; rowsum += v; }
            const float wi = expf(bt + m - mloc); float qn = 0.f;
            _Pragma("unroll 1") for (int d = 0; d < 128; ++d) qn += bf2f(qs[t * 136 + d]) * ns[d];
            const float den = rowsum + wi * qn;
            dinv[t] = 1.0f / fmaxf(fabsf(den), expf(-mloc)); wint[t] = wi; }
        __syncthreads();
        { const int t = tid >> 3, j = tid & 7; float vals[16], qc[16];
#pragma unroll
            for (int k = 0; k < 16; ++k) { vals[k] = 0.f; qc[k] = 0.f; }
            _Pragma("unroll 1") for (int s = 0; s <= t; ++s) { const float sv = Ss[t * 65 + s];
#pragma unroll
                for (int k = 0; k < 16; ++k) vals[k] += sv * bf2f(vs[s * 136 + j * 16 + k]); }
            _Pragma("unroll 1") for (int d = 0; d < 128; ++d) { const float qd = bf2f(qs[t * 136 + d]);
#pragma unroll
                for (int k = 0; k < 16; ++k) qc[k] += qd * Cs[d * 128 + j * 16 + k]; }
            const float wi = wint[t], di = dinv[t]; float ss = 0.f;
#pragma unroll
            for (int k = 0; k < 16; ++k) { vals[k] = (vals[k] + wi * qc[k]) * di; ss += vals[k] * vals[k]; }
            ss += __shfl_xor(ss, 1); ss += __shfl_xor(ss, 2); ss += __shfl_xor(ss, 4);
            const float rstd = 1.0f / sqrtf(ss * (1.0f / 128.0f) + EPS);
#pragma unroll
            for (int k = 0; k < 16; ++k) { const int col = h * 128 + j * 16 + k; const float mo = bf2f(U[(t0 + t) * NU + 1536 + col]);
                HM[(t0 + t) * 1024 + col] = (bf16)f2bf(vals[k] * rstd * gnorm[col] * (1.0f / (1.0f + expf(-mo)))); } }
        __syncthreads();
        const float bL = bs[63]; float m_new = bL + m;
        _Pragma("unroll 1") for (int s = 0; s < 64; ++s) m_new = fmaxf(m_new, bL - bs[s] + lis[s]);
        const float decay = expf(bL + m - m_new);
        if (tid < 64) wgs[tid] = expf(bL - bs[tid] + lis[tid] - m_new);
        __syncthreads();
        { const int e = tid & 127, dg = tid >> 7;
            _Pragma("unroll 1") for (int dd = 0; dd < 32; ++dd) { const int d = dg * 32 + dd; float acc = decay * Cs[d * 128 + e];
                _Pragma("unroll 1") for (int s = 0; s < 64; ++s) acc += wgs[s] * bf2f(ks[s * 136 + d]) * bf2f(vs[s * 136 + e]);
                Cs[d * 128 + e] = acc; } }
        if (tid < 128) { const int d = tid; float acc = decay * ns[d]; _Pragma("unroll 1") for (int s = 0; s < 64; ++s) acc += wgs[s] * bf2f(ks[s * 136 + d]); ns[d] = acc; }
        m = m_new;
        __syncthreads();
    }
}
__device__ __forceinline__ void gla_scalar(LAS unsigned char* lds, int b, int h, const bf16* QG, const bf16* KG, const bf16* KW, const bf16* U, const float* EBL, const float* gnorm, bf16* HM) {
    const int tid = threadIdx.x;
    LAS bf16* qg = (LAS bf16*)lds;
    LAS bf16* kg = qg + 64 * 72; LAS bf16* kw = kg + 64 * 72;
    LAS bf16* vs = kw + 64 * 72;
    LAS float* As = (LAS float*)(lds + 45056);
    LAS float* St = (LAS float*)(lds + 61696);
    LAS float* ebl = (LAS float*)(lds + 94464);
    LAS float* hs = (LAS float*)lds;
    for (int i = tid; i < 64 * 128; i += 512) St[i] = 0.f;
    __syncthreads();
    for (int c = 0; c < 64; ++c) {
        const size_t t0 = (size_t)b * SEQ + (size_t)c * 64;
        { const int t = tid >> 3, cc = tid & 7;
            *(LAS v4u*)(qg + t * 72 + cc * 8) = *(const v4u*)(QG + (t0 + t) * 256 + h * 64 + cc * 8);
            *(LAS v4u*)(kg + t * 72 + cc * 8) = *(const v4u*)(KG + (t0 + t) * 256 + h * 64 + cc * 8);
            *(LAS v4u*)(kw + t * 72 + cc * 8) = *(const v4u*)(KW + (t0 + t) * 256 + h * 64 + cc * 8); }
        for (int i = tid; i < 1024; i += 512) { const int t = i >> 4, cc = i & 15; *(LAS v4u*)(vs + t * 136 + cc * 8) = *(const v4u*)(U + (t0 + t) * NU + 2560 + h * 128 + cc * 8); }
        if (tid < 64) ebl[tid] = EBL[((size_t)b * 64 + c) * 256 + h * 64 + tid];
        __syncthreads();
        { const int t = tid >> 3, sg = tid & 7;
            for (int i = 0; i < 8; ++i) { const int s = sg + 8 * i; if (s <= t) { float acc = 0.f; _Pragma("unroll 1") for (int d = 0; d < 64; ++d) acc += bf2f(qg[t * 72 + d]) * bf2f(kg[s * 72 + d]); As[t * 65 + s] = acc; } } }
        __syncthreads();
        { const int t = tid >> 3, j = tid & 7; float vals[16];
#pragma unroll
            for (int k = 0; k < 16; ++k) vals[k] = 0.f;
            _Pragma("unroll 1") for (int s = 0; s <= t; ++s) { const float sv = As[t * 65 + s];
#pragma unroll
                for (int k = 0; k < 16; ++k) vals[k] += sv * bf2f(vs[s * 136 + j * 16 + k]); }
            _Pragma("unroll 1") for (int d = 0; d < 64; ++d) { const float qd = bf2f(qg[t * 72 + d]);
#pragma unroll
                for (int k = 0; k < 16; ++k) vals[k] += qd * St[d * 128 + j * 16 + k]; }
            float ss = 0.f;
#pragma unroll
            for (int k = 0; k < 16; ++k) ss += vals[k] * vals[k];
            ss += __shfl_xor(ss, 1); ss += __shfl_xor(ss, 2); ss += __shfl_xor(ss, 4);
            const float rstd = 1.0f / sqrtf(ss * (1.0f / 128.0f) + EPS);
#pragma unroll
            for (int k = 0; k < 16; ++k) { const int col = h * 128 + j * 16 + k; const float gr = bf2f(U[(t0 + t) * NU + 3072 + col]);
                HM[(t0 + t) * 1024 + 512 + col] = (bf16)f2bf(vals[k] * rstd * gnorm[col] * (gr / (1.0f + expf(-gr)))); } }
        __syncthreads();
        { const int e = tid & 127, dg = tid >> 7;
            _Pragma("unroll 1") for (int dd = 0; dd < 16; ++dd) { const int d = dg * 16 + dd; float acc = ebl[d] * St[d * 128 + e];
                _Pragma("unroll 1") for (int s = 0; s < 64; ++s) acc += bf2f(kw[s * 72 + d]) * bf2f(vs[s * 136 + e]);
                St[d * 128 + e] = acc; } }
        __syncthreads();
    }
}
__device__ __forceinline__ void phase_mixers_scalar(const Args& a, LAS unsigned char* lds, int G) {
    unsigned char* ws = a.ws;
    for (int w = blockIdx.x; w < 128; w += G) {
        if (w < 64) mlstm_scalar(lds, w >> 2, w & 3, (const bf16*)(ws + WS_QM), (const bf16*)(ws + WS_KM), (const bf16*)(ws + WS_U), (const float*)(ws + WS_LI), (const float*)(ws + WS_BF), a.in[I_MNG], (bf16*)(ws + WS_HM));
        else gla_scalar(lds, (w - 64) >> 2, (w - 64) & 3, (const bf16*)(ws + WS_QG), (const bf16*)(ws + WS_KG), (const bf16*)(ws + WS_KW), (const bf16*)(ws + WS_U), (const float*)(ws + WS_EBL), a.in[I_GNG], (bf16*)(ws + WS_HM));
        __syncthreads();
    }
}
__device__ __forceinline__ void phase_softmax(const float* SC, bf16* P, int G) {
    const int lane = threadIdx.x & 63, wave = threadIdx.x >> 6, gw = blockIdx.x * NWAVES + wave, NGW = G * NWAVES;
    for (int r = gw; r < T * 4; r += NGW) {
        const f32x4 v = *((const f32x4*)(SC + (size_t)r * 256) + lane);
        const float mx = wave_max(fmaxf(fmaxf(v.x, v.y), fmaxf(v.z, v.w)));
        const float e0 = expf(v.x - mx), e1 = expf(v.y - mx), e2 = expf(v.z - mx), e3 = expf(v.w - mx);
        const float inv = 1.0f / wave_sum((e0 + e1) + (e2 + e3));
        *((v2u*)(P + (size_t)r * 256) + lane) = (v2u){pk2(e0 * inv, e1 * inv), pk2(e2 * inv, e3 * inv)};
    }
}
__device__ __forceinline__ void phase_final(float* out, const float* ssp, const float* g, int G) {
    const int lane = threadIdx.x & 63, wave = threadIdx.x >> 6, gw = blockIdx.x * NWAVES + wave, NGW = G * NWAVES;
    f32x4 gv[4];
#pragma unroll
    for (int j = 0; j < 4; ++j) gv[j] = ((const f32x4*)g)[lane + 64 * j];
    for (int m = gw; m < T; m += NGW) {
        const float s = wave_sum(lane < 16 ? ssp[(size_t)m * 16 + lane] : 0.f);
        const float rs = 1.0f / sqrtf(s * (1.0f / DM) + EPS);
        f32x4* xr = (f32x4*)(out + (size_t)m * DM) + lane;
#pragma unroll
        for (int j = 0; j < 4; ++j) { f32x4 v = xr[64 * j]; xr[64 * j] = v * rs * gv[j]; }
    }
}

#ifndef MK_N_LAUNCHES
#define MK_N_LAUNCHES 1
#endif
constexpr int NPHASES = 13;
__global__ void __launch_bounds__(NWAVES * 64, 2) fwd_kernel(Args args) {
    extern __shared__ __attribute__((aligned(16))) unsigned char lds_raw[];
    LAS unsigned char* lds = (LAS unsigned char*)lds_raw;
    const int tid = threadIdx.x, G = gridDim.x, bid = blockIdx.x;
    unsigned char* ws = args.ws;
    volatile LAS unsigned* MISC = (volatile LAS unsigned*)(lds + MISC_OFF);
    for (int u = tid; u < (LDS_BYTES - MISC_OFF) / 4; u += NWAVES * 64) ((LAS unsigned*)(lds + MISC_OFF))[u] = 0u;
    __syncthreads();
    XcdBarrier bar; bar.bar = (unsigned*)(ws + WS_CTL) + CW_BAR; bar.x = 0; bar.st = nullptr;
    if (MK_N_LAUNCHES == 1) bar = xcd_barrier_post((unsigned*)(ws + WS_CTL) + CW_BAR, MISC + 8);
    const int lo = args.ph_lo, hi = args.ph_hi;
#ifndef PH_MASK
#define PH_MASK 0x1fff
#endif
#define IN(k) (((PH_MASK >> (k)) & 1) && lo <= (k) && (k) < hi)
#define SEAM(k) do { if (IN(k) && IN((k) + 1)) xcd_barrier(bar); } while (0)
    using namespace pg8;
    const bf16_t* XB = (const bf16_t*)(ws + WS_XB);
    if (IN(0)) { phase_prologue(args, lds, G); SEAM(0); }
    if (IN(1)) {
        { Gemm g{XB, (const bf16_t*)(ws + WS_WIN), 1024, 1024, 1024}; StaticOrder S; S.init(T, NINP, G, bid);
          typedef Epi<1, 0, 0, 0, 0, 1> E_t; E_t E{(void*)(ws + WS_U), NU, (const float*)(ws + WS_RSTD0), 1.f, nullptr, nullptr, (float*)(ws + WS_GATES)};
          gemm_phase<E_t, StaticOrder, true, true>(lds, g, S, E); }
        { Gemm g{(const bf16_t*)(ws + WS_MEMN), (const bf16_t*)(ws + WS_WK), 1024, 1024, 1024}; StaticOrder S; S.init(TMEM, 1024, G, bid);
          typedef Epi<0, 0, 0, 0, 0, 0> E_t; E_t E{(void*)(ws + WS_KB), 1024, nullptr, 1.f, nullptr, nullptr, nullptr};
          gemm_phase<E_t, StaticOrder, true, true>(lds, g, S, E); }
        { Gemm g{(const bf16_t*)(ws + WS_WV), (const bf16_t*)(ws + WS_MEMN), 1024, 1024, 1024}; StaticOrder S; S.init(1024, TMEM, G, bid);
          typedef Epi<0, 0, 0, 0, 0, 0> E_t; E_t E{(void*)(ws + WS_VT), 4096, nullptr, 1.f, nullptr, nullptr, nullptr};
          gemm_phase<E_t, StaticOrder, true, true>(lds, g, S, E); }
        SEAM(1);
    }
    if (IN(2)) { phase_prep(args, lds, G); SEAM(2); }
    if (IN(3)) { phase_mixers_scalar(args, lds, G); SEAM(3); }
    if (IN(4)) {
        Gemm g{(const bf16_t*)(ws + WS_HM), (const bf16_t*)(ws + WS_WOUT), 1024, 1024, 1024}; StaticOrder S; S.init(T, 1024, G, bid);
        typedef Epi<0, 0, 1, 0, 1, 0> E_t; E_t E{(void*)(ws + WS_X1), 1024, nullptr, 1.f, (const void*)args.in[I_X], (float*)(ws + WS_SSP1), nullptr};
        gemm_phase<E_t, StaticOrder, true, true>(lds, g, S, E); SEAM(4);
    }
    if (IN(5)) {
        Gemm g{(const bf16_t*)(ws + WS_X1), (const bf16_t*)(ws + WS_WQ), 1024, 1024, 1024}; StaticOrder S; S.init(T, 1024, G, bid);
        typedef Epi<2, 0, 0, 0, 0, 0> E_t; E_t E{(void*)(ws + WS_HQ), 1024, (const float*)(ws + WS_SSP1), 0.0625f, nullptr, nullptr, nullptr};
        gemm_phase<E_t, StaticOrder, true, true>(lds, g, S, E); SEAM(5);
    }
    if (IN(6)) {
        Gemm g{(const bf16_t*)(ws + WS_HQ), (const bf16_t*)(ws + WS_KB), 1024, 1024, 256}; AttnOrder<0> S{G, bid};
        typedef Epi<0, 0, 0, 1, 0, 0> E_t; E_t E{(void*)args.out, 1024, nullptr, 1.f, nullptr, nullptr, nullptr};
        gemm_phase<E_t, AttnOrder<0>, true, true>(lds, g, S, E); SEAM(6);
    }
    if (IN(7)) { phase_softmax(args.out, (bf16*)(ws + WS_P), G); SEAM(7); }
    if (IN(8)) {
        Gemm g{(const bf16_t*)(ws + WS_P), (const bf16_t*)(ws + WS_VT), 1024, 4096, 256}; AttnOrder<1> S{G, bid};
        typedef Epi<0, 0, 0, 0, 0, 0> E_t; E_t E{(void*)(ws + WS_ATT), 1024, nullptr, 1.f, nullptr, nullptr, nullptr};
        gemm_phase<E_t, AttnOrder<1>, true, true>(lds, g, S, E); SEAM(8);
    }
    if (IN(9)) {
        Gemm g{(const bf16_t*)(ws + WS_ATT), (const bf16_t*)(ws + WS_WO), 1024, 1024, 1024}; StaticOrder S; S.init(T, 1024, G, bid);
        typedef Epi<0, 0, 2, 0, 1, 0> E_t; E_t E{(void*)(ws + WS_X2), 1024, nullptr, 1.f, (const void*)(ws + WS_X1), (float*)(ws + WS_SSP2), nullptr};
        gemm_phase<E_t, StaticOrder, true, true>(lds, g, S, E); SEAM(9);
    }
    if (IN(10)) {
        Gemm g{(const bf16_t*)(ws + WS_X2), (const bf16_t*)(ws + WS_W1), 1024, 1024, 1024}; StaticOrder S; S.init(T, DFF, G, bid);
        typedef Epi<2, 1, 0, 0, 0, 0> E_t; E_t E{(void*)(ws + WS_HID), DFF, (const float*)(ws + WS_SSP2), 1.f, nullptr, nullptr, nullptr};
        gemm_phase<E_t, StaticOrder, true, true>(lds, g, S, E); SEAM(10);
    }
    if (IN(11)) {
        Gemm g{(const bf16_t*)(ws + WS_HID), (const bf16_t*)(ws + WS_W2), DFF, DFF, DFF}; StaticOrder S; S.init(T, 1024, G, bid);
        typedef Epi<0, 0, 2, 1, 1, 0> E_t; E_t E{(void*)args.out, 1024, nullptr, 1.f, (const void*)(ws + WS_X2), (float*)(ws + WS_SSP3), nullptr};
        gemm_phase<E_t, StaticOrder, true, true>(lds, g, S, E); SEAM(11);
    }
    if (IN(12)) phase_final(args.out, (const float*)(ws + WS_SSP3), args.in[I_FING], G);
#undef IN
#undef SEAM
}

extern "C" void kernel_launch(void* const* d_in, const int* in_sizes, int n_in, void* d_out, int out_size, void* d_ws, size_t ws_size, hipStream_t stream) {
    static int grid = 0;
    if (grid == 0) {
        if (n_in != 23 || in_sizes[0] != T * DM || out_size != T * DM || ws_size < WS_END) { fprintf(stderr, "kernel_launch: unexpected shapes (n_in %d, in0 %d, out %d, ws %zu); nothing launched\n", n_in, n_in > 0 ? in_sizes[0] : -1, out_size, ws_size); grid = -1; return; }
        int dev = 0, cus = 0;
        if (hipGetDevice(&dev) != hipSuccess || hipDeviceGetAttribute(&cus, hipDeviceAttributeMultiprocessorCount, dev) != hipSuccess) { grid = -1; return; }
        if (hipFuncSetAttribute((const void*)fwd_kernel, hipFuncAttributeMaxDynamicSharedMemorySize, LDS_BYTES) != hipSuccess) { fprintf(stderr, "kernel_launch: hipFuncSetAttribute failed\n"); grid = -1; return; }
        int per_cu = 0;
        if (hipOccupancyMaxActiveBlocksPerMultiprocessor(&per_cu, (const void*)fwd_kernel, NWAVES * 64, LDS_BYTES) != hipSuccess || per_cu < 1) fprintf(stderr, "kernel_launch: occupancy query reports %d\n", per_cu);
        (void)hipGetLastError();
        grid = cus;
    }
    if (grid < 0) return;
    (void)hipMemsetAsync((char*)d_ws + WS_CTL, 0, CTL_ZERO_BYTES, stream);
    Args a{};
    for (int i = 0; i < 23; ++i) a.in[i] = (const float*)d_in[i];
    a.out = (float*)d_out; a.ws = (unsigned char*)d_ws;
    if (MK_N_LAUNCHES == 1) { a.ph_lo = 0; a.ph_hi = NPHASES; hipLaunchKernelGGL(fwd_kernel, dim3(grid), dim3(NWAVES * 64), LDS_BYTES, stream, a); }
    else for (int p = 0; p < NPHASES; ++p) { a.ph_lo = p; a.ph_hi = p + 1; hipLaunchKernelGGL(fwd_kernel, dim3(grid), dim3(NWAVES * 64), LDS_BYTES, stream, a); }
}
```

```cpp
#include <hip/hip_runtime.h>
#include <cstdio>
#include <cstdint>
namespace pg8 {
#define PG8_LAS __attribute__((address_space(3)))
typedef unsigned short bf16_t;
typedef short bf16x8 __attribute__((ext_vector_type(8)));
typedef float f32x4 __attribute__((ext_vector_type(4)));
typedef unsigned u32x4 __attribute__((ext_vector_type(4)));
constexpr int BM = 256, BK = 64, HALF = 128, HTB = HALF * BK * 2  , STAGE_BYTES = 8 * HTB, NXCD = 8, WGM = 8;

__host__ __device__ __forceinline__ int lds_byte(int r, int c) { const int st = (r >> 4) * 2 + (c >> 5), rr = r & 15, cc = c & 31, ob = rr * 64 + cc * 2; return st * 1024 + (ob ^ (((ob >> 9) & 1) << 5)); }
__host__ __device__ __forceinline__ void stage_rc(int b, int& R, int& C) { const int st = b / 1024, sb = b % 1024, swz = sb ^ (((sb >> 9) & 1) << 5); R = (st >> 1) * 16 + swz / 64; C = (st & 1) * 32 + (swz % 64) / 2; }
__host__ __device__ __forceinline__ int perm32(int rho) { const int n = rho >> 4, i = rho & 15; return 8 * (i >> 2) + 4 * n + (i & 3); }


struct Unit { int pm, pn; };
struct Gemm { const bf16_t* A; const bf16_t* Bt; int lda, ldb, K; };

struct StaticOrder {
    int nM, nN, nwg, G, c;
    __host__ __device__ void init(int M, int N, int G_, int c_) { nM = M / BM; nN = N / BM; nwg = nM * nN; G = G_; c = c_; }
    __host__ __device__ bool next(int i, Unit& u) const {
        const long L = (long)i * G + c; if (L >= nwg) return false;
        int wgid = (int)L; { const int q = nwg / NXCD, r = nwg % NXCD, xcd = wgid % NXCD, off = wgid / NXCD; wgid = (xcd < r ? xcd * (q + 1) : r * (q + 1) + (xcd - r) * q) + off; }
        const int nig = WGM * nN, gid = wgid / nig, fm = gid * WGM, gsz = (nM - fm) < WGM ? (nM - fm) : WGM;
        u.pm = fm + ((wgid % nig) % gsz); u.pn = (wgid % nig) / gsz; return true;
    }
    __device__ __forceinline__ const char* aptr(const Gemm& g, const Unit& u) const { return (const char*)g.A + (size_t)u.pm * BM * g.lda * 2; }
    __device__ __forceinline__ const char* bptr(const Gemm& g, const Unit& u) const { return (const char*)g.Bt + (size_t)u.pn * BM * g.ldb * 2; }
    __device__ __forceinline__ void a_ready(const Unit&) const {}
    __device__ __forceinline__ void done(const Unit&) const {}
};
template <int MODE> struct AttnOrder {
    int G, c;
    __device__ bool next(int i, Unit& u) const { const long L = (long)i * G + c; if (L >= 1024) return false; u.pm = (int)(L >> 2); u.pn = (int)(L & 3); return true; }
    __device__ __forceinline__ const char* aptr(const Gemm& g, const Unit& u) const { return (const char*)g.A + ((size_t)u.pm * 256 * 1024 + (size_t)u.pn * 256) * 2; }
    __device__ __forceinline__ const char* bptr(const Gemm& g, const Unit& u) const {
        return MODE == 0 ? (const char*)g.Bt + ((size_t)(u.pm >> 4) * 256 * 1024 + (size_t)u.pn * 256) * 2
                         : (const char*)g.Bt + ((size_t)u.pn * 256 * 4096 + (size_t)(u.pm >> 4) * 256) * 2; }
    __device__ __forceinline__ void a_ready(const Unit&) const {}
    __device__ __forceinline__ void done(const Unit&) const {}
};

__device__ __forceinline__ unsigned cvt_pk_bf16(float lo, float hi) { unsigned r; asm volatile("v_cvt_pk_bf16_f32 %0, %1, %2" : "=v"(r) : "v"(lo), "v"(hi)); return r; }
__device__ __forceinline__ float bf_lo(unsigned w) { return __uint_as_float(w << 16); }
__device__ __forceinline__ float bf_hi(unsigned w) { return __uint_as_float(w & 0xffff0000u); }

template <int RS  , int ACT, int RES, int OUTF32, int SSQ, int GATE>
struct Epi {
    static constexpr bool PERM = true, AFTER_DRAIN = false;
    void* out; int ldc; const float* rs; float scale; const void* base; float* ssp; float* gates;
    __device__ __forceinline__ void operator()(const f32x4 (&acc)[2][2][4][2], const Unit& u, int wr, int wc, int fr, int fq) const {
        const int row0 = u.pm * BM + wr * 64 + fr, col0 = u.pn * BM + wc * 32 + 8 * fq;
        const bool gate_tile = GATE && (u.pn == 14);
#pragma unroll
        for (int ai = 0; ai < 2; ++ai)
#pragma unroll
            for (int m = 0; m < 4; ++m) {
                const int r = row0 + ai * HALF + m * 16;
                float rsv = scale;
                if (RS == 1) rsv *= rs[r];
                if (RS == 2) { const f32x4* p = (const f32x4*)(rs + (size_t)r * 16); const f32x4 a = p[0], b = p[1], c = p[2], d = p[3];
                    const float s = ((a[0] + a[1]) + (a[2] + a[3])) + ((b[0] + b[1]) + (b[2] + b[3])) + ((c[0] + c[1]) + (c[2] + c[3])) + ((d[0] + d[1]) + (d[2] + d[3]));
                    rsv *= 1.0f / sqrtf(s * (1.0f / 1024.0f) + 1e-6f); }
                float ss = 0.f;
#pragma unroll
                for (int bj = 0; bj < 2; ++bj) {
                    f32x4 v0 = acc[ai][bj][m][0] * rsv, v1 = acc[ai][bj][m][1] * rsv;
                    if (ACT == 1) { v0 = __builtin_elementwise_max(v0, (f32x4){0.f, 0.f, 0.f, 0.f}); v1 = __builtin_elementwise_max(v1, (f32x4){0.f, 0.f, 0.f, 0.f}); v0 = v0 * v0; v1 = v1 * v1; }
                    const size_t off = (size_t)r * ldc + col0 + bj * HALF;
                    if (RES == 1) { const f32x4* bp = (const f32x4*)((const float*)base + off); v0 = v0 + bp[0]; v1 = v1 + bp[1]; }
                    if (RES == 2) { const u32x4 w = *(const u32x4*)((const bf16_t*)base + off);
                        v0 = v0 + (f32x4){bf_lo(w.x), bf_hi(w.x), bf_lo(w.y), bf_hi(w.y)}; v1 = v1 + (f32x4){bf_lo(w.z), bf_hi(w.z), bf_lo(w.w), bf_hi(w.w)}; }
                    if (SSQ) ss += ((v0[0] * v0[0] + v0[1] * v0[1]) + (v0[2] * v0[2] + v0[3] * v0[3])) + ((v1[0] * v1[0] + v1[1] * v1[1]) + (v1[2] * v1[2] + v1[3] * v1[3]));
                    if (gate_tile) { if (bj == 0 && wc == 0 && fq < 3) { f32x4* gp = (f32x4*)(gates + (size_t)r * 32 + 8 * fq); gp[0] = v0; gp[1] = v1; } }
                    else if (OUTF32) { f32x4* op = (f32x4*)((float*)out + off); op[0] = v0; op[1] = v1; }
                    else { u32x4 w; w.x = cvt_pk_bf16(v0[0], v0[1]); w.y = cvt_pk_bf16(v0[2], v0[3]); w.z = cvt_pk_bf16(v1[0], v1[1]); w.w = cvt_pk_bf16(v1[2], v1[3]);
                        *(u32x4*)((bf16_t*)out + off) = w; }
                }
                if (SSQ) { ss += __shfl_xor(ss, 16); ss += __shfl_xor(ss, 32); if (fq == 0) ssp[(size_t)r * 16 + u.pn * 4 + wc] = ss; }
                if (RS == 2 || RES != 0) asm volatile("" ::: "memory");
            }
    }
};

template <class Epi, class Sched, bool ALIGN_EPI = false, bool SP2 = false>
__device__ __forceinline__ void gemm_phase(PG8_LAS unsigned char* lds, const Gemm g, const Sched& S, const Epi& E) {
    const int tid = threadIdx.x, wid = __builtin_amdgcn_readfirstlane(tid >> 6), lane = tid & 63, wr = wid >> 2, wc = wid & 3, fr = lane & 15, fq = lane >> 4;
    const int K = g.K, nt = K / BK;
    unsigned voffA[2], voffB[2];
#pragma unroll
    for (int i = 0; i < 2; ++i) { int R, C; stage_rc(tid * 16 + i * 8192, R, C); const int Rb = Epi::PERM ? ((R & ~31) + perm32(R & 31)) : R;
        voffA[i] = (unsigned)(R * g.lda + C) * 2u; voffB[i] = (unsigned)(Rb * g.ldb + C) * 2u; }
    const size_t kstep = (size_t)(BK * 2);
    const size_t hstepA = (size_t)HALF * g.lda * 2, hstepB = (size_t)HALF * g.ldb * 2;
    const unsigned ldsw = (unsigned)wid * 1024u;
    const int aoff = lds_byte(wr * 64 + fr, fq * 8), boff = lds_byte(wc * 32 + fr, fq * 8);
#define PG8_SA(b, h) (((b) * 2 + (h)) * HTB)
#define PG8_SB(b, h) ((4 + (b) * 2 + (h)) * HTB)
#define PG8_STAGE(bufoff, gbase, voff) do { _Pragma("unroll") for (int _i = 0; _i < 2; ++_i) \
        __builtin_amdgcn_global_load_lds((const unsigned*)((const char*)(gbase) + (voff)[_i]), (PG8_LAS unsigned*)(lds + (bufoff) + ldsw + _i * 8192), 16, 0, 0); } while (0)
#define PG8_LDA(dst, b, h) do { _Pragma("unroll") for (int m = 0; m < 4; ++m) _Pragma("unroll") for (int k = 0; k < 2; ++k) dst[m][k] = *(const PG8_LAS bf16x8*)(lds + PG8_SA(b, h) + aoff + m * 2048 + k * 1024); } while (0)
#define PG8_LDB(dst, b, h) do { _Pragma("unroll") for (int n = 0; n < 2; ++n) _Pragma("unroll") for (int k = 0; k < 2; ++k) dst[n][k] = *(const PG8_LAS bf16x8*)(lds + PG8_SB(b, h) + boff + n * 2048 + k * 1024); } while (0)
#define PG8_MMA(ai, bj, At, Bt) do { __builtin_amdgcn_s_setprio(1); _Pragma("unroll") for (int m = 0; m < 4; ++m) _Pragma("unroll") for (int n = 0; n < 2; ++n) _Pragma("unroll") for (int k = 0; k < 2; ++k) \
        acc[ai][bj][m][n] = __builtin_amdgcn_mfma_f32_16x16x32_bf16(Bt[n][k], At[m][k], acc[ai][bj][m][n], 0, 0, 0); __builtin_amdgcn_s_setprio(0); } while (0)
#define PG8_WAIT_V(n) asm volatile("s_waitcnt vmcnt(" #n ")" ::: "memory")
#define PG8_WAIT_L(n) asm volatile("s_waitcnt lgkmcnt(" #n ")" ::: "memory")
#define PG8_BAR __builtin_amdgcn_s_barrier()
#define PG8_SCHED __builtin_amdgcn_sched_barrier(0)
    Unit cur, nxt; int ui = 0;
    if (!S.next(0, cur)) return;
    f32x4 acc[2][2][4][2];
#pragma unroll
    for (int a = 0; a < 2; ++a)
#pragma unroll
        for (int b = 0; b < 2; ++b)
#pragma unroll
            for (int m = 0; m < 4; ++m)
#pragma unroll
                for (int n = 0; n < 2; ++n) acc[a][b][m][n] = (f32x4){0.f, 0.f, 0.f, 0.f};
    bf16x8 At[4][2], B0[2][2], B1[2][2];
    const char* cA = S.aptr(g, cur); const char* cB = S.bptr(g, cur);
    S.a_ready(cur);
    if constexpr (SP2) {
        PG8_STAGE(PG8_SB(0, 0), cB, voffB); PG8_STAGE(PG8_SB(0, 1), cB + hstepB, voffB); PG8_STAGE(PG8_SA(0, 0), cA, voffA); PG8_STAGE(PG8_SA(0, 1), cA + hstepA, voffA);
        if (wr == 1) PG8_BAR;
        PG8_WAIT_V(2); PG8_BAR;
        PG8_STAGE(PG8_SB(1, 0), cB + kstep, voffB); PG8_STAGE(PG8_SA(1, 0), cA + kstep, voffA); PG8_STAGE(PG8_SB(1, 1), cB + hstepB + kstep, voffB);
        PG8_WAIT_V(6); PG8_BAR;
    } else {
        PG8_STAGE(PG8_SB(0, 0), cB, voffB); PG8_STAGE(PG8_SA(0, 0), cA, voffA); PG8_STAGE(PG8_SB(0, 1), cB + hstepB, voffB); PG8_STAGE(PG8_SA(0, 1), cA + hstepA, voffA);
        if (wr == 1) PG8_BAR;
        PG8_WAIT_V(4); PG8_BAR;
        PG8_STAGE(PG8_SB(1, 0), cB + kstep, voffB); PG8_STAGE(PG8_SA(1, 0), cA + kstep, voffA); PG8_STAGE(PG8_SB(1, 1), cB + hstepB + kstep, voffB);
        PG8_WAIT_V(6); PG8_BAR;
    }
    for (;;) {
        const bool has_next = S.next(ui + 1, nxt);
        const char* nA = has_next ? S.aptr(g, nxt) : cA; const char* nB = has_next ? S.bptr(g, nxt) : cB;
        _Pragma("unroll 1") for (int t = 0; t < nt; t += 2) {
            const bool last = (t == nt - 2);
            const char* a1 = cA + (size_t)(t + 1) * kstep;
            const char* a2 = last ? nA : cA + (size_t)(t + 2) * kstep; const char* b2 = last ? nB : cB + (size_t)(t + 2) * kstep;
            const char* a3 = a2 + kstep; const char* b3 = b2 + kstep;
            if (last && has_next) S.a_ready(nxt);
            if constexpr (SP2) {
            PG8_LDB(B0, 0, 0); PG8_LDB(B1, 0, 1); PG8_SCHED; PG8_LDA(At, 0, 0); PG8_STAGE(PG8_SA(1, 1), a1 + hstepA, voffA);
            PG8_WAIT_V(8); PG8_WAIT_L(0); PG8_BAR; PG8_MMA(0, 0, At, B0); PG8_MMA(0, 1, At, B1); PG8_BAR; PG8_SCHED;
            PG8_LDA(At, 0, 1); PG8_STAGE(PG8_SB(0, 0), b2, voffB); PG8_STAGE(PG8_SB(0, 1), b2 + hstepB, voffB); PG8_STAGE(PG8_SA(0, 0), a2, voffA);
            PG8_WAIT_V(8); PG8_WAIT_L(0); PG8_BAR; PG8_MMA(1, 0, At, B0); PG8_MMA(1, 1, At, B1); PG8_BAR; PG8_SCHED;
            PG8_LDB(B0, 1, 0); PG8_LDB(B1, 1, 1); PG8_SCHED; PG8_LDA(At, 1, 0); PG8_STAGE(PG8_SA(0, 1), a2 + hstepA, voffA);
            PG8_WAIT_V(8); PG8_WAIT_L(0); PG8_BAR; PG8_MMA(0, 0, At, B0); PG8_MMA(0, 1, At, B1); PG8_BAR; PG8_SCHED;
            PG8_LDA(At, 1, 1); PG8_STAGE(PG8_SB(1, 0), b3, voffB); PG8_STAGE(PG8_SB(1, 1), b3 + hstepB, voffB); PG8_STAGE(PG8_SA(1, 0), a3, voffA);
            PG8_WAIT_V(8); PG8_WAIT_L(0); PG8_BAR; PG8_MMA(1, 0, At, B0); PG8_MMA(1, 1, At, B1); PG8_BAR; PG8_SCHED;
            } else {
            PG8_LDB(B0, 0, 0); PG8_SCHED; PG8_LDA(At, 0, 0); PG8_STAGE(PG8_SA(1, 1), a1 + hstepA, voffA);
            PG8_WAIT_L(8); PG8_BAR; PG8_WAIT_L(0); PG8_MMA(0, 0, At, B0); PG8_BAR; PG8_SCHED;
            PG8_LDB(B1, 0, 1); PG8_STAGE(PG8_SB(0, 0), b2, voffB);
            PG8_BAR; PG8_WAIT_L(0); PG8_MMA(0, 1, At, B1); PG8_BAR;
            PG8_LDA(At, 0, 1); PG8_STAGE(PG8_SA(0, 0), a2, voffA);
            PG8_BAR; PG8_WAIT_L(0); PG8_MMA(1, 0, At, B0); PG8_BAR; PG8_SCHED;
            PG8_STAGE(PG8_SB(0, 1), b2 + hstepB, voffB);
            PG8_WAIT_V(6); PG8_BAR; PG8_MMA(1, 1, At, B1); PG8_BAR;
            PG8_LDB(B0, 1, 0); PG8_SCHED; PG8_LDA(At, 1, 0); PG8_STAGE(PG8_SA(0, 1), a2 + hstepA, voffA);
            PG8_WAIT_L(8); PG8_BAR; PG8_WAIT_L(0); PG8_MMA(0, 0, At, B0); PG8_BAR; PG8_SCHED;
            PG8_LDB(B1, 1, 1); PG8_STAGE(PG8_SB(1, 0), b3, voffB);
            PG8_BAR; PG8_WAIT_L(0); PG8_MMA(0, 1, At, B1); PG8_BAR;
            PG8_LDA(At, 1, 1); PG8_STAGE(PG8_SA(1, 0), a3, voffA);
            PG8_BAR; PG8_WAIT_L(0); PG8_MMA(1, 0, At, B0); PG8_BAR; PG8_SCHED;
            PG8_STAGE(PG8_SB(1, 1), b3 + hstepB, voffB);
            PG8_WAIT_V(6); PG8_BAR; PG8_MMA(1, 1, At, B1); PG8_BAR;
            }
        }
        if constexpr (ALIGN_EPI) { if (wr == 0) PG8_BAR; }
        if constexpr (!Epi::AFTER_DRAIN) { E(acc, cur, wr, wc, fr, fq); S.done(cur); }
        if (!has_next) break;
#pragma unroll
        for (int a = 0; a < 2; ++a)
#pragma unroll
            for (int b = 0; b < 2; ++b)
#pragma unroll
                for (int m = 0; m < 4; ++m)
#pragma unroll
                    for (int n = 0; n < 2; ++n) acc[a][b][m][n] = (f32x4){0.f, 0.f, 0.f, 0.f};
        cur = nxt; cA = nA; cB = nB; ++ui;
        if constexpr (ALIGN_EPI) { if (wr == 1) PG8_BAR; }
    }
    PG8_WAIT_V(0);
    if constexpr (!ALIGN_EPI) { if (wr == 0) PG8_BAR; }
    PG8_BAR;
    if constexpr (Epi::AFTER_DRAIN) { E.fused(acc, cur, wr, wc, fr, fq, lds, wid, lane); S.done(cur); }
#undef PG8_SA
#undef PG8_SB
#undef PG8_STAGE
#undef PG8_LDA
#undef PG8_LDB
#undef PG8_MMA
#undef PG8_WAIT_V
#undef PG8_WAIT_L
#undef PG8_BAR
#undef PG8_SCHED
}
}

constexpr int NWAVES = 8;
constexpr int BATCH = 16, SEQ = 4096, DM = 1024, T = BATCH * SEQ, MEML = 256, TMEM = BATCH * MEML, DFF = 4096, NU = 3584, NINP = 3840;
constexpr float EPS = 1e-6f;
constexpr size_t MiB = 1u << 20;
constexpr size_t WS_CTL = 0, CTL_ZERO_BYTES = 1 * MiB;
constexpr size_t WS_WIN = 2 * MiB, WS_WOUT = 10 * MiB, WS_WQ = 12 * MiB, WS_WK = 14 * MiB, WS_WV = 16 * MiB, WS_WO = 18 * MiB, WS_W1 = 20 * MiB, WS_W2 = 28 * MiB;
constexpr size_t WS_MEMN = 36 * MiB, WS_KB = 44 * MiB, WS_VT = 52 * MiB, WS_RSTD0 = 60 * MiB, WS_SSP1 = 61 * MiB, WS_SSP2 = 65 * MiB, WS_SSP3 = 69 * MiB;
constexpr size_t WS_GATES = 73 * MiB, WS_LI = 81 * MiB, WS_BF = 82 * MiB, WS_EBL = 83 * MiB;
constexpr size_t WS_XB = 96 * MiB, WS_X1 = 96 * MiB, WS_U = 224 * MiB, WS_QM = 672 * MiB, WS_KM = 736 * MiB, WS_QG = 800 * MiB, WS_KG = 832 * MiB, WS_KW = 864 * MiB;
constexpr size_t WS_HM = 896 * MiB, WS_X2 = 896 * MiB, WS_HQ = 224 * MiB, WS_P = 352 * MiB, WS_ATT = 480 * MiB, WS_HID = 224 * MiB, WS_END = 1024 * MiB;
constexpr size_t WS_NST = 84 * MiB, WS_KS = 86 * MiB, WS_MST = 88 * MiB, WS_BLM = 88 * MiB + 65536, WS_GMX = 88 * MiB + 131072, WS_CT = 96 * MiB;
constexpr size_t DO_KWM = 0, DO_ST = 64 * MiB;
constexpr int CW_BAR = 4096;
constexpr int LDS_BYTES = 163840, MISC_OFF = LDS_BYTES - 512;

#define LAS __attribute__((address_space(3)))
typedef unsigned short bf16;
typedef unsigned v4u __attribute__((ext_vector_type(4)));
typedef unsigned v2u __attribute__((ext_vector_type(2)));
typedef float f32x4 __attribute__((ext_vector_type(4)));
#define LDS_WAIT() asm volatile("s_waitcnt lgkmcnt(0)" ::: "memory")
__device__ __forceinline__ unsigned f2bf(float f) { unsigned u = __builtin_bit_cast(unsigned, f); return (u + 0x7fffu + ((u >> 16) & 1u)) >> 16; }
__device__ __forceinline__ unsigned pk2(float lo, float hi) { return f2bf(lo) | (f2bf(hi) << 16); }
__device__ __forceinline__ float bf2f(bf16 v) { return __uint_as_float((unsigned)v << 16); }
__device__ __forceinline__ float wave_sum(float v) {
#pragma unroll
    for (int o = 1; o < 64; o <<= 1) v += __shfl_xor(v, o);
    return v;
}
__device__ __forceinline__ float wave_max(float v) {
#pragma unroll
    for (int o = 1; o < 64; o <<= 1) v = fmaxf(v, __shfl_xor(v, o));
    return v;
}
__device__ __forceinline__ float logsig(float x) { return fminf(x, 0.f) - log1pf(expf(-fabsf(x))); }

#define XB_TMO      128
#define XB_XCNT(j)  (256  + 64 * (j))
#define XB_XSUB(j)  (1280 + 64 * (j))
#define XB_XGEN(j)  (2304 + 64 * (j))
#define XB_TOP      3328
#define XB_TOPGEN   3392
#define XCD_BAR_WORDS 3456
#define XB_SPIN_CAP (1u << 18)

__device__ __forceinline__ unsigned xb_ld(unsigned* p)              { return __hip_atomic_load(p, __ATOMIC_RELAXED, __HIP_MEMORY_SCOPE_AGENT); }
__device__ __forceinline__ unsigned xb_add(unsigned* p, unsigned v) { return __hip_atomic_fetch_add(p, v, __ATOMIC_RELAXED, __HIP_MEMORY_SCOPE_AGENT); }
__device__ __forceinline__ unsigned xb_xcc_id() { return (unsigned)__builtin_amdgcn_s_getreg((3 << 11) | 20) & 0xFu; }
#define XB_SPIN(cond, bar) do { unsigned _sp = 0; while (cond) { __builtin_amdgcn_s_sleep(1); \
    if ((++_sp & 255u) == 0u) { if (xb_ld(&(bar)[XB_TMO])) break; if (_sp > XB_SPIN_CAP) { atomicAdd(&(bar)[XB_TMO], 1u); break; } } } } while (0)

struct XcdBarrier {
    unsigned* bar; unsigned x;
    volatile LAS unsigned* st;
};

__device__ __forceinline__ XcdBarrier xcd_barrier_post(unsigned* bar, volatile LAS unsigned* st) {
    XcdBarrier b; b.bar = bar; b.x = xb_xcc_id(); b.st = st;
    if (threadIdx.x == 0) (void)xb_add(&bar[XB_XCNT(b.x)], 1u);
    return b;
}
__device__ __forceinline__ void xcd_barrier_complete(unsigned* bar, unsigned x, unsigned& nloc, unsigned& nx) {
    const unsigned G = gridDim.x * gridDim.y * gridDim.z;
    unsigned sum, cnt, mine, sp = 0u;
    for (;;) {
        sum = 0u; cnt = 0u; mine = 0u;
#pragma unroll
        for (unsigned j = 0; j < 16; ++j) { const unsigned c = xb_ld(&bar[XB_XCNT(j)]); sum += c; cnt += (c > 0u) ? 1u : 0u; mine = (j == x) ? c : mine; }
        if (sum == G) break;
        __builtin_amdgcn_s_sleep(1);
        if ((++sp & 255u) == 0u) { if (xb_ld(&bar[XB_TMO])) break; if (sp > XB_SPIN_CAP) { atomicAdd(&bar[XB_TMO], 1u); break; } }
    }
    nloc = mine > 0u ? mine : 1u; nx = cnt > 0u ? cnt : 1u;
}

__device__ __forceinline__ void xcd_barrier(const XcdBarrier& b) {
    asm volatile("s_waitcnt vmcnt(0)" ::: "memory");
    __syncthreads();
    if (threadIdx.x == 0) {
        unsigned* bar = b.bar;
        __builtin_amdgcn_s_waitcnt(0);
        unsigned nloc = b.st[0], nx = b.st[1];
        if (nloc == 0u) { xcd_barrier_complete(bar, b.x, nloc, nx); b.st[0] = nloc; b.st[1] = nx; }
        const unsigned old = xb_add(&bar[XB_XSUB(b.x)], 1u);
        const unsigned gen = old / nloc;
        if (old + 1u == (gen + 1u) * nloc) {
            __builtin_amdgcn_fence(__ATOMIC_RELEASE, "agent");
            asm volatile("s_waitcnt vmcnt(0)" ::: "memory");
            const unsigned og = xb_add(&bar[XB_TOP], 1u);
            const unsigned tg = og / nx;
            if (og + 1u == (tg + 1u) * nx) xb_add(&bar[XB_TOPGEN], 1u);
            else XB_SPIN(xb_ld(&bar[XB_TOPGEN]) == tg, bar);
            __builtin_amdgcn_fence(__ATOMIC_ACQUIRE, "agent");
            xb_add(&bar[XB_XGEN(b.x)], 1u);
            asm volatile("s_waitcnt vmcnt(0)" ::: "memory");
        } else {
            XB_SPIN(xb_ld(&bar[XB_XGEN(b.x)]) == gen, bar);
            __builtin_amdgcn_fence(__ATOMIC_ACQUIRE, "agent");
            asm volatile("s_waitcnt vmcnt(0)" ::: "memory");
        }
    }
    __syncthreads();
}

struct Args { const float* in[23]; float* out; unsigned char* ws; int ph_lo, ph_hi; };
enum { I_X = 0, I_MEM, I_MIXG, I_WIN, I_CONVW, I_CONVB, I_IB, I_FB, I_MNG, I_WA2, I_BA, I_GNG, I_WOUT, I_XAG, I_MEMG, I_WQ, I_WK, I_WV, I_WO, I_MLPG, I_W1, I_W2, I_FING };

__device__ __forceinline__ int map_col(int mode, int nd) {
    if (mode == 0) return nd;
    if (nd < 2048) return nd; if (nd < 3584) return nd + 8; if (nd < 3592) return nd - 3584 + 2048; if (nd < 3608) return nd; return -1;
}
__device__ __forceinline__ void p0_transpose_item(const float* W, int K, int N, const float* gain, bf16* WT, int ndst_blk, int mode, LAS float* scr, int item, int lane) {
    const int kb = item / ndst_blk, nb = item % ndst_blk, k0 = 64 * kb, n0 = 32 * nb;
    const int ns = map_col(mode, n0 + (lane & 31));
#pragma unroll 8
    for (int i = 0; i < 32; ++i) { const int kk = 2 * i + (lane >> 5); float v = 0.f; if (ns >= 0) { v = W[(size_t)(k0 + kk) * N + ns]; if (gain) v *= gain[k0 + kk]; } scr[kk * 33 + (lane & 31)] = v; }
    LDS_WAIT(); asm volatile("" ::: "memory");
    const int c = lane & 7;
#pragma unroll
    for (int j = 0; j < 4; ++j) { const int n = (lane >> 3) + 8 * j; const LAS float* s = scr + (8 * c) * 33 + n;
        v4u o; o.x = pk2(s[0 * 33], s[1 * 33]); o.y = pk2(s[2 * 33], s[3 * 33]); o.z = pk2(s[4 * 33], s[5 * 33]); o.w = pk2(s[6 * 33], s[7 * 33]);
        *(v4u*)(WT + (size_t)(n0 + n) * K + k0 + 8 * c) = o; }
    LDS_WAIT(); asm volatile("" ::: "memory");
}

__device__ __forceinline__ void phase_prologue(const Args& a, LAS unsigned char* lds, int G) {
    const int tid = threadIdx.x, lane = tid & 63, wave = tid >> 6;
    unsigned char* ws = a.ws;
    LAS float* scr = (LAS float*)(lds + wave * 16384);
    const int gw = blockIdx.x * NWAVES + wave, NGW = G * NWAVES;
    constexpr int I_IN = 16 * 120, I_SQ = 16 * 32, I_1 = 16 * 128, I_2 = 64 * 32;
    constexpr int NITEMS = I_IN + 5 * I_SQ + I_1 + I_2;
    for (int it = gw; it < NITEMS; it += NGW) {
        int r = it;
        if (r < I_IN) { p0_transpose_item(a.in[I_WIN], 1024, 3608, a.in[I_MIXG], (bf16*)(ws + WS_WIN), 120, 1, scr, r, lane); continue; } r -= I_IN;
        if (r < I_SQ) { p0_transpose_item(a.in[I_WOUT], 1024, 1024, nullptr, (bf16*)(ws + WS_WOUT), 32, 0, scr, r, lane); continue; } r -= I_SQ;
        if (r < I_SQ) { p0_transpose_item(a.in[I_WQ], 1024, 1024, a.in[I_XAG], (bf16*)(ws + WS_WQ), 32, 0, scr, r, lane); continue; } r -= I_SQ;
        if (r < I_SQ) { p0_transpose_item(a.in[I_WK], 1024, 1024, a.in[I_MEMG], (bf16*)(ws + WS_WK), 32, 0, scr, r, lane); continue; } r -= I_SQ;
        if (r < I_SQ) { p0_transpose_item(a.in[I_WV], 1024, 1024, a.in[I_MEMG], (bf16*)(ws + WS_WV), 32, 0, scr, r, lane); continue; } r -= I_SQ;
        if (r < I_SQ) { p0_transpose_item(a.in[I_WO], 1024, 1024, nullptr, (bf16*)(ws + WS_WO), 32, 0, scr, r, lane); continue; } r -= I_SQ;
        if (r < I_1) { p0_transpose_item(a.in[I_W1], 1024, 4096, a.in[I_MLPG], (bf16*)(ws + WS_W1), 128, 0, scr, r, lane); continue; } r -= I_1;
        p0_transpose_item(a.in[I_W2], 4096, 1024, nullptr, (bf16*)(ws + WS_W2), 32, 0, scr, r, lane);
    }
    const float* x = a.in[I_X]; bf16* XB = (bf16*)(ws + WS_XB); float* rstd0 = (float*)(ws + WS_RSTD0);
    for (int m = gw; m < T; m += NGW) {
        const f32x4* xr = (const f32x4*)(x + (size_t)m * DM) + lane; f32x4 v[4]; float s = 0.f;
#pragma unroll
        for (int j = 0; j < 4; ++j) { v[j] = xr[64 * j]; s += (v[j].x * v[j].x + v[j].y * v[j].y) + (v[j].z * v[j].z + v[j].w * v[j].w); }
        s = wave_sum(s);
        if (lane == 0) rstd0[m] = 1.0f / sqrtf(s * (1.0f / DM) + EPS);
        v2u* o8 = (v2u*)(XB + (size_t)m * DM) + lane;
#pragma unroll
        for (int j = 0; j < 4; ++j) o8[64 * j] = (v2u){pk2(v[j].x, v[j].y), pk2(v[j].z, v[j].w)};
    }
    const float* mem = a.in[I_MEM]; bf16* MEMN = (bf16*)(ws + WS_MEMN);
    for (int m = gw; m < TMEM; m += NGW) {
        const f32x4* xr = (const f32x4*)(mem + (size_t)m * DM) + lane; f32x4 v[4]; float s = 0.f;
#pragma unroll
        for (int j = 0; j < 4; ++j) { v[j] = xr[64 * j]; s += (v[j].x * v[j].x + v[j].y * v[j].y) + (v[j].z * v[j].z + v[j].w * v[j].w); }
        s = wave_sum(s);
        const float rs = 1.0f / sqrtf(s * (1.0f / DM) + EPS);
        v2u* o8 = (v2u*)(MEMN + (size_t)m * DM) + lane;
#pragma unroll
        for (int j = 0; j < 4; ++j) o8[64 * j] = (v2u){pk2(v[j].x * rs, v[j].y * rs), pk2(v[j].z * rs, v[j].w * rs)};
    }
}


__device__ __forceinline__ float fast_logsig(float x) { return fminf(x, 0.f) - __logf(1.0f + __expf(-fabsf(x))); }
__device__ __forceinline__ void unpack8(const v4u r, float (&o)[8]) { o[0] = pg8::bf_lo(r.x); o[1] = pg8::bf_hi(r.x); o[2] = pg8::bf_lo(r.y); o[3] = pg8::bf_hi(r.y); o[4] = pg8::bf_lo(r.z); o[5] = pg8::bf_hi(r.z); o[6] = pg8::bf_lo(r.w); o[7] = pg8::bf_hi(r.w); }
__device__ __forceinline__ v4u pack8(const float (&y)[8]) { return (v4u){pg8::cvt_pk_bf16(y[0], y[1]), pg8::cvt_pk_bf16(y[2], y[3]), pg8::cvt_pk_bf16(y[4], y[5]), pg8::cvt_pk_bf16(y[6], y[7])}; }
__device__ __forceinline__ void phase_prep(const Args& a, LAS unsigned char* lds, int G) {
    const int tid = threadIdx.x;
    unsigned char* ws = a.ws;
    const bf16* U = (const bf16*)(ws + WS_U); const float* gates = (const float*)(ws + WS_GATES);
    bf16* QM = (bf16*)(ws + WS_QM); bf16* KM = (bf16*)(ws + WS_KM); bf16* QG = (bf16*)(ws + WS_QG); bf16* KG = (bf16*)(ws + WS_KG); bf16* KW = (bf16*)(ws + WS_KW);
    bf16* KWM = (bf16*)((unsigned char*)a.out + DO_KWM);
    float* LI = (float*)(ws + WS_LI); float* BF = (float*)(ws + WS_BF); float* EBL = (float*)(ws + WS_EBL);
    float* KS = (float*)(ws + WS_KS); float* BLM = (float*)(ws + WS_BLM); float* GMX = (float*)(ws + WS_GMX);
    LAS float* gl = (LAS float*)lds;
    LAS float* LIS = gl + 64 * 32;
    LAS float* BSM = LIS + 256;
    LAS float* WGL = BSM + 256;
    LAS float* SC8 = WGL + 256;
    LAS float* BL = SC8 + 64;
    LAS float* KSP = BL + 64 * 256;
    for (int ci = blockIdx.x; ci < T / 64; ci += G) {
        const size_t t0 = (size_t)ci * 64; const bool first = (ci & 63) == 0;
        ((LAS f32x4*)gl)[tid] = ((const f32x4*)(gates + t0 * 32))[tid];
        __syncthreads();
        if (tid < 256) { const int t = tid >> 2, h = tid & 3; const float li = gl[t * 32 + h] + a.in[I_IB][h];
            LIS[t * 4 + h] = li; BSM[t * 4 + h] = fast_logsig(gl[t * 32 + 4 + h] + a.in[I_FB][h]); LI[(t0 + t) * 4 + h] = li; }
        { const int c = tid & 255, th = tid >> 8; const float* wa2 = a.in[I_WA2]; float w[16];
#pragma unroll
            for (int r = 0; r < 16; ++r) w[r] = wa2[r * 256 + c];
            const float ba = a.in[I_BA][c];
            for (int tt = 0; tt < 32; ++tt) { const int t = th * 32 + tt; float xa = ba;
#pragma unroll
                for (int r = 0; r < 16; ++r) xa += gl[t * 32 + 8 + r] * w[r];
                BL[t * 256 + c] = fast_logsig(xa) * (1.0f / 16.0f); } }
        __syncthreads();
        if (tid < 4) { const int h = tid; float run = 0.f;
            for (int t = 0; t < 64; ++t) { run += BSM[t * 4 + h]; BSM[t * 4 + h] = run; }
            float gm = -3.0e38f;
            for (int t = 0; t < 64; ++t) gm = fmaxf(gm, run - BSM[t * 4 + h] + LIS[t * 4 + h]);
            SC8[h] = run; SC8[4 + h] = gm; BLM[ci * 4 + h] = run; GMX[ci * 4 + h] = gm; }
        if (tid >= 256) { const int c = tid - 256; float run = 0.f;
            for (int t = 0; t < 64; ++t) { run += BL[t * 256 + c]; BL[t * 256 + c] = run; } }
        __syncthreads();
        if (tid < 256) { const int t = tid >> 2, h = tid & 3; const float bt = BSM[t * 4 + h];
            WGL[t * 4 + h] = __expf(SC8[h] - bt + LIS[t * 4 + h] - SC8[4 + h]); BF[(t0 + t) * 4 + h] = bt; }
        __syncthreads();
        {
            const int cg = tid & 127, tg = tid >> 7, c0 = cg * 8, tl0 = tg * 16;
            const float* cw = a.in[I_CONVW]; const float* cb = a.in[I_CONVB];
            float w0[8], w1[8], w2[8], w3[8], bb[8], xm3[8], xm2[8], xm1[8], ksum[8];
#pragma unroll
            for (int i = 0; i < 8; ++i) { w0[i] = cw[c0 + i]; w1[i] = cw[1024 + c0 + i]; w2[i] = cw[2048 + c0 + i]; w3[i] = cw[3072 + c0 + i]; bb[i] = cb[c0 + i]; ksum[i] = 0.f; }
            { v4u r3 = {0, 0, 0, 0}, r2 = {0, 0, 0, 0}, r1 = {0, 0, 0, 0};
              if (tl0 > 0 || !first) { r3 = *(const v4u*)(U + (t0 + tl0 - 3) * NU + c0); r2 = *(const v4u*)(U + (t0 + tl0 - 2) * NU + c0); r1 = *(const v4u*)(U + (t0 + tl0 - 1) * NU + c0); }
              unpack8(r3, xm3); unpack8(r2, xm2); unpack8(r1, xm1); }
            const bool isq = c0 < 512; const int hk = (c0 - 512) >> 7;
            for (int tt = 0; tt < 16; ++tt) {
                const size_t t = t0 + tl0 + tt;
                float xc[8], y[8]; unpack8(*(const v4u*)(U + t * NU + c0), xc);
#pragma unroll
                for (int i = 0; i < 8; ++i) { const float v = bb[i] + w0[i] * xm3[i] + w1[i] * xm2[i] + w2[i] * xm1[i] + w3[i] * xc[i]; y[i] = v / (1.0f + __expf(-v)); xm3[i] = xm2[i]; xm2[i] = xm1[i]; xm1[i] = xc[i]; }
                if (isq) {
#pragma unroll
                    for (int i = 0; i < 8; ++i) y[i] *= 0.08838834764831845f;
                    *(v4u*)(QM + t * 512 + c0) = pack8(y);
                } else {
                    *(v4u*)(KM + t * 512 + (c0 - 512)) = pack8(y);
                    const float wg = WGL[(tl0 + tt) * 4 + hk];
#pragma unroll
                    for (int i = 0; i < 8; ++i) { y[i] *= wg; ksum[i] += y[i]; }
                    *(v4u*)(KWM + t * 512 + (c0 - 512)) = pack8(y);
                }
            }
            if (!isq) {
#pragma unroll
                for (int i = 0; i < 8; ++i) KSP[tg * 512 + (c0 - 512) + i] = ksum[i]; }
        }
        {
            const int c8 = (tid & 31) * 8;
#pragma unroll
            for (int i = 0; i < 4; ++i) { const int t = (tid >> 5) + 16 * i;
                float q[8], k[8], oq[8], ok[8], ow[8];
                unpack8(*(const v4u*)(U + (t0 + t) * NU + 2048 + c8), q); unpack8(*(const v4u*)(U + (t0 + t) * NU + 2304 + c8), k);
#pragma unroll
                for (int j = 0; j < 8; ++j) { const float b = BL[t * 256 + c8 + j], bL = BL[63 * 256 + c8 + j]; oq[j] = q[j] * 0.125f * __expf(b); ok[j] = k[j] * __expf(-b); ow[j] = k[j] * __expf(bL - b); }
                *(v4u*)(QG + (t0 + t) * 256 + c8) = pack8(oq); *(v4u*)(KG + (t0 + t) * 256 + c8) = pack8(ok); *(v4u*)(KW + (t0 + t) * 256 + c8) = pack8(ow);
            }
            if (tid < 256) EBL[(size_t)ci * 256 + tid] = __expf(BL[63 * 256 + tid]);
        }
        __syncthreads();
        KS[(size_t)ci * 512 + tid] = (KSP[tid] + KSP[512 + tid]) + (KSP[1024 + tid] + KSP[1536 + tid]);
        __syncthreads();
    }
}

__device__ __forceinline__ void mlstm_scalar(LAS unsigned char* lds, int b, int h, const bf16* QM, const bf16* KM, const bf16* U, const float* LI, const float* BF, const float* gnorm, bf16* HM) {
    const int tid = threadIdx.x;
    LAS bf16* qs = (LAS bf16*)lds;
    LAS bf16* ks = qs + 64 * 136;
    LAS bf16* vs = ks + 64 * 136;
    LAS float* Ss = (LAS float*)(lds + 52224);
    LAS float* Cs = (LAS float*)(lds + 68864);
    LAS float* ns = (LAS float*)(lds + 134400);
    LAS float* bs = ns + 128; LAS float* lis = bs + 64; LAS float* wint = lis + 64; LAS float* dinv = wint + 64; LAS float* wgs = dinv + 64;
    LAS float* hs = (LAS float*)lds;
    for (int i = tid; i < 128 * 128; i += 512) Cs[i] = 0.f;
    if (tid < 128) ns[tid] = 0.f;
    float m = 0.f;
    __syncthreads();
    for (int c = 0; c < 64; ++c) {
        const size_t t0 = (size_t)b * SEQ + (size_t)c * 64;
        for (int i = tid; i < 1024; i += 512) { const int t = i >> 4, cc = i & 15;
            *(LAS v4u*)(qs + t * 136 + cc * 8) = *(const v4u*)(QM + (t0 + t) * 512 + h * 128 + cc * 8);
            *(LAS v4u*)(ks + t * 136 + cc * 8) = *(const v4u*)(KM + (t0 + t) * 512 + h * 128 + cc * 8);
            *(LAS v4u*)(vs + t * 136 + cc * 8) = *(const v4u*)(U + (t0 + t) * NU + 1024 + h * 128 + cc * 8); }
        if (tid < 64) { bs[tid] = BF[(t0 + tid) * 4 + h]; lis[tid] = LI[(t0 + tid) * 4 + h]; }
        __syncthreads();
        { const int t = tid >> 3, sg = tid & 7;
            for (int i = 0; i < 8; ++i) { const int s = sg + 8 * i; if (s <= t) { float acc = 0.f; _Pragma("unroll 1") for (int d = 0; d < 128; ++d) acc += bf2f(qs[t * 136 + d]) * bf2f(ks[s * 136 + d]); Ss[t * 65 + s] = acc; } } }
        __syncthreads();
        if (tid < 64) { const int t = tid; const float bt = bs[t]; float mloc = bt + m;
            _Pragma("unroll 1") for (int s = 0; s <= t; ++s) mloc = fmaxf(mloc, bt - bs[s] + lis[s]);
            float rowsum = 0.f;
            _Pragma("unroll 1") for (int s = 0; s <= t; ++s) { const float v = Ss[t * 65 + s] * expf(bt - bs[s] + lis[s] - mloc); Ss[t * 65 + s] = v; rowsum += v; }
            const float wi = expf(bt + m - mloc); float qn = 0.f;
            _Pragma("unroll 1") for (int d = 0; d < 128; ++d) qn += bf2f(qs[t * 136 + d]) * ns[d];
            const float den = rowsum + wi * qn;
            dinv[t] = 1.0f / fmaxf(fabsf(den), expf(-mloc)); wint[t] = wi; }
        __syncthreads();
        { const int t = tid >> 3, j = tid & 7; float vals[16], qc[16];
#pragma unroll
            for (int k = 0; k < 16; ++k) { vals[k] = 0.f; qc[k] = 0.f; }
            _Pragma("unroll 1") for (int s = 0; s <= t; ++s) { const float sv = Ss[t * 65 + s];
#pragma unroll
                for (int k = 0; k < 16; ++k) vals[k] += sv * bf2f(vs[s * 136 + j * 16 + k]); }
            _Pragma("unroll 1") for (int d = 0; d < 128; ++d) { const float qd = bf2f(qs[t * 136 + d]);
#pragma unroll
                for (int k = 0; k < 16; ++k) qc[k] += qd * Cs[d * 128 + j * 16 + k]; }
            const float wi = wint[t], di = dinv[t]; float ss = 0.f;
#pragma unroll
            for (int k = 0; k < 16; ++k) { vals[k] = (vals[k] + wi * qc[k]) * di; ss += vals[k] * vals[k]; }
            ss += __shfl_xor(ss, 1); ss += __shfl_xor(ss, 2); ss += __shfl_xor(ss, 4);
            const float rstd = 1.0f / sqrtf(ss * (1.0f / 128.0f) + EPS);
#pragma unroll
            for (int k = 0; k < 16; ++k) { const int col = h * 128 + j * 16 + k; const float mo = bf2f(U[(t0 + t) * NU + 1536 + col]);
                HM[(t0 + t) * 1024 + col] = (bf16)f2bf(vals[k] * rstd * gnorm[col] * (1.0f / (1.0f + expf(-mo)))); } }
        __syncthreads();
        const float bL = bs[63]; float m_new = bL + m;
        _Pragma("unroll 1") for (int s = 0; s < 64; ++s) m_new = fmaxf(m_new, bL - bs[s] + lis[s]);
        const float decay = expf(bL + m - m_new);
        if (tid < 64) wgs[tid] = expf(bL - bs[tid] + lis[tid] - m_new);
        __syncthreads();
        { const int e = tid & 127, dg = tid >> 7;
            _Pragma("unroll 1") for (int dd = 0; dd < 32; ++dd) { const int d = dg * 32 + dd; float acc = decay * Cs[d * 128 + e];
                _Pragma("unroll 1") for (int s = 0; s < 64; ++s) acc += wgs[s] * bf2f(ks[s * 136 + d]) * bf2f(vs[s * 136 + e]);
                Cs[d * 128 + e] = acc; } }
        if (tid < 128) { const int d = tid; float acc = decay * ns[d]; _Pragma("unroll 1") for (int s = 0; s < 64; ++s) acc += wgs[s] * bf2f(ks[s * 136 + d]); ns[d] = acc; }
        m = m_new;
        __syncthreads();
    }
}
__device__ __forceinline__ void gla_scalar(LAS unsigned char* lds, int b, int h, const bf16* QG, const bf16* KG, const bf16* KW, const bf16* U, const float* EBL, const float* gnorm, bf16* HM) {
    const int tid = threadIdx.x;
    LAS bf16* qg = (LAS bf16*)lds;
    LAS bf16* kg = qg + 64 * 72; LAS bf16* kw = kg + 64 * 72;
    LAS bf16* vs = kw + 64 * 72;
    LAS float* As = (LAS float*)(lds + 45056);
    LAS float* St = (LAS float*)(lds + 61696);
    LAS float* ebl = (LAS float*)(lds + 94464);
    LAS float* hs = (LAS float*)lds;
    for (int i = tid; i < 64 * 128; i += 512) St[i] = 0.f;
    __syncthreads();
    for (int c = 0; c < 64; ++c) {
        const size_t t0 = (size_t)b * SEQ + (size_t)c * 64;
        { const int t = tid >> 3, cc = tid & 7;
            *(LAS v4u*)(qg + t * 72 + cc * 8) = *(const v4u*)(QG + (t0 + t) * 256 + h * 64 + cc * 8);
            *(LAS v4u*)(kg + t * 72 + cc * 8) = *(const v4u*)(KG + (t0 + t) * 256 + h * 64 + cc * 8);
            *(LAS v4u*)(kw + t * 72 + cc * 8) = *(const v4u*)(KW + (t0 + t) * 256 + h * 64 + cc * 8); }
        for (int i = tid; i < 1024; i += 512) { const int t = i >> 4, cc = i & 15; *(LAS v4u*)(vs + t * 136 + cc * 8) = *(const v4u*)(U + (t0 + t) * NU + 2560 + h * 128 + cc * 8); }
        if (tid < 64) ebl[tid] = EBL[((size_t)b * 64 + c) * 256 + h * 64 + tid];
        __syncthreads();
        { const int t = tid >> 3, sg = tid & 7;
            for (int i = 0; i < 8; ++i) { const int s = sg + 8 * i; if (s <= t) { float acc = 0.f; _Pragma("unroll 1") for (int d = 0; d < 64; ++d) acc += bf2f(qg[t * 72 + d]) * bf2f(kg[s * 72 + d]); As[t * 65 + s] = acc; } } }
        __syncthreads();
        { const int t = tid >> 3, j = tid & 7; float vals[16];
#pragma unroll
            for (int k = 0; k < 16; ++k) vals[k] = 0.f;
            _Pragma("unroll 1") for (int s = 0; s <= t; ++s) { const float sv = As[t * 65 + s];
#pragma unroll
                for (int k = 0; k < 16; ++k) vals[k] += sv * bf2f(vs[s * 136 + j * 16 + k]); }
            _Pragma("unroll 1") for (int d = 0; d < 64; ++d) { const float qd = bf2f(qg[t * 72 + d]);
#pragma unroll
                for (int k = 0; k < 16; ++k) vals[k] += qd * St[d * 128 + j * 16 + k]; }
            float ss = 0.f;
#pragma unroll
            for (int k = 0; k < 16; ++k) ss += vals[k] * vals[k];
            ss += __shfl_xor(ss, 1); ss += __shfl_xor(ss, 2); ss += __shfl_xor(ss, 4);
            const float rstd = 1.0f / sqrtf(ss * (1.0f / 128.0f) + EPS);
#pragma unroll
            for (int k = 0; k < 16; ++k) { const int col = h * 128 + j * 16 + k; const float gr = bf2f(U[(t0 + t) * NU + 3072 + col]);
                HM[(t0 + t) * 1024 + 512 + col] = (bf16)f2bf(vals[k] * rstd * gnorm[col] * (gr / (1.0f + expf(-gr)))); } }
        __syncthreads();
        { const int e = tid & 127, dg = tid >> 7;
            _Pragma("unroll 1") for (int dd = 0; dd < 16; ++dd) { const int d = dg * 16 + dd; float acc = ebl[d] * St[d * 128 + e];
                _Pragma("unroll 1") for (int s = 0; s < 64; ++s) acc += bf2f(kw[s * 72 + d]) * bf2f(vs[s * 136 + e]);
                St[d * 128 + e] = acc; } }
        __syncthreads();
    }
}
__device__ __forceinline__ void phase_mixers_scalar(const Args& a, LAS unsigned char* lds, int G) {
    unsigned char* ws = a.ws;
    for (int w = blockIdx.x; w < 128; w += G) {
        if (w < 64) mlstm_scalar(lds, w >> 2, w & 3, (const bf16*)(ws + WS_QM), (const bf16*)(ws + WS_KM), (const bf16*)(ws + WS_U), (const float*)(ws + WS_LI), (const float*)(ws + WS_BF), a.in[I_MNG], (bf16*)(ws + WS_HM));
        else gla_scalar(lds, (w - 64) >> 2, (w - 64) & 3, (const bf16*)(ws + WS_QG), (const bf16*)(ws + WS_KG), (const bf16*)(ws + WS_KW), (const bf16*)(ws + WS_U), (const float*)(ws + WS_EBL), a.in[I_GNG], (bf16*)(ws + WS_HM));
        __syncthreads();
    }
}
__device__ __forceinline__ void phase_softmax(const float* SC, bf16* P, int G) {
    const int lane = threadIdx.x & 63, wave = threadIdx.x >> 6, gw = blockIdx.x * NWAVES + wave, NGW = G * NWAVES;
    for (int r = gw; r < T * 4; r += NGW) {
        const f32x4 v = *((const f32x4*)(SC + (size_t)r * 256) + lane);
        const float mx = wave_max(fmaxf(fmaxf(v.x, v.y), fmaxf(v.z, v.w)));
        const float e0 = expf(v.x - mx), e1 = expf(v.y - mx), e2 = expf(v.z - mx), e3 = expf(v.w - mx);
        const float inv = 1.0f / wave_sum((e0 + e1) + (e2 + e3));
        *((v2u*)(P + (size_t)r * 256) + lane) = (v2u){pk2(e0 * inv, e1 * inv), pk2(e2 * inv, e3 * inv)};
    }
}
__device__ __forceinline__ void phase_final(float* out, const float* ssp, const float* g, int G) {
    const int lane = threadIdx.x & 63, wave = threadIdx.x >> 6, gw = blockIdx.x * NWAVES + wave, NGW = G * NWAVES;
    f32x4 gv[4];
#pragma unroll
    for (int j = 0; j < 4; ++j) gv[j] = ((const f32x4*)g)[lane + 64 * j];
    for (int m = gw; m < T; m += NGW) {
        const float s = wave_sum(lane < 16 ? ssp[(size_t)m * 16 + lane] : 0.f);
        const float rs = 1.0f / sqrtf(s * (1.0f / DM) + EPS);
        f32x4* xr = (f32x4*)(out + (size_t)m * DM) + lane;
#pragma unroll
        for (int j = 0; j < 4; ++j) { f32x4 v = xr[64 * j]; xr[64 * j] = v * rs * gv[j]; }
    }
}

typedef short bf16x8 __attribute__((ext_vector_type(8)));
typedef short s16x4 __attribute__((ext_vector_type(4)));
#define MFMA16(x, y, acc) __builtin_amdgcn_mfma_f32_16x16x32_bf16((x), (y), (acc), 0, 0, 0)
__device__ __forceinline__ bf16x8 frag_n(const LAS bf16* base, int LD, int r0, int k0, int lane) { return *(const LAS bf16x8*)(base + (r0 + (lane & 15)) * LD + k0 + 8 * (lane >> 4)); }
__device__ __forceinline__ bf16x8 frag_t(const LAS bf16* base, int LD, int k0, int n0, int lane) {
    const int g = lane >> 4, q = (lane & 15) >> 2, p = lane & 3;
    const LAS bf16* a0 = base + (k0 + 8 * g + q) * LD + n0 + 4 * p;
    const s16x4 lo = __builtin_bit_cast(s16x4, __builtin_amdgcn_ds_read_tr16_b64_v4i16((LAS s16x4*)a0));
    const s16x4 hi = __builtin_bit_cast(s16x4, __builtin_amdgcn_ds_read_tr16_b64_v4i16((LAS s16x4*)(a0 + 4 * LD)));
    return __builtin_shufflevector(lo, hi, 0, 1, 2, 3, 4, 5, 6, 7);
}

__device__ __forceinline__ void phase_chain(const Args& a, LAS unsigned char* lds, int G) {
    const int tid = threadIdx.x, lane = tid & 63, w = __builtin_amdgcn_readfirstlane(tid >> 6), g = lane >> 4;
    unsigned char* ws = a.ws;
    const bf16* U = (const bf16*)(ws + WS_U); const bf16* KWM = (const bf16*)((const unsigned char*)a.out + DO_KWM); const bf16* KW = (const bf16*)(ws + WS_KW);
    bf16* CT = (bf16*)(ws + WS_CT); bf16* ST = (bf16*)((unsigned char*)a.out + DO_ST);
    float* NST = (float*)(ws + WS_NST); float* MST = (float*)(ws + WS_MST);
    const float* KS = (const float*)(ws + WS_KS); const float* BLM = (const float*)(ws + WS_BLM); const float* GMX = (const float*)(ws + WS_GMX); const float* EBL = (const float*)(ws + WS_EBL);
    const int bx = blockIdx.x, vcu = (G % 8 == 0) ? (bx % 8) * (G / 8) + bx / 8 : bx;
    constexpr int BUF = 36864, O_KWM = 0, O_KWG = 17408, O_VM = 26624, O_VG = 31744;
    for (int wk = vcu; wk < 256; wk += G) {
        const int bh = wk >> 2, q = wk & 3, b = bh >> 2, h = bh & 3;
        const bf16* kwm_g = KWM + (size_t)b * SEQ * 512 + h * 128;
        const bf16* kwg_g = KW + (size_t)b * SEQ * 256 + h * 64;
        const bf16* v_g = U + (size_t)b * SEQ * NU + (tid < 256 ? 1024 + h * 128 + 32 * q : 2560 + h * 128 + 32 * q);
        const int r01 = tid >> 4, c01 = (tid & 15) * 8, r2 = tid >> 3, c2 = (tid & 7) * 8, r3 = (tid & 255) >> 2, c3 = (tid & 3) * 8;
        f32x4 cm[2] = {{0.f, 0.f, 0.f, 0.f}, {0.f, 0.f, 0.f, 0.f}}, cgs = {0.f, 0.f, 0.f, 0.f};
        float m = 0.f, nreg = 0.f;
        v4u p0, p1, p2, p3;
        { p0 = *(const v4u*)(kwm_g + (size_t)r01 * 512 + c01); p1 = *(const v4u*)(kwm_g + (size_t)(r01 + 32) * 512 + c01);
          p2 = *(const v4u*)(kwg_g + (size_t)r2 * 256 + c2); p3 = *(const v4u*)(v_g + (size_t)r3 * NU + c3); }
        { LAS unsigned char* Bf = lds;
          *(LAS v4u*)(Bf + O_KWM + (r01 * 136 + c01) * 2) = p0; *(LAS v4u*)(Bf + O_KWM + ((r01 + 32) * 136 + c01) * 2) = p1;
          *(LAS v4u*)(Bf + O_KWG + (r2 * 72 + c2) * 2) = p2; *(LAS v4u*)(Bf + (tid < 256 ? O_VM : O_VG) + (r3 * 40 + c3) * 2) = p3; }
        for (int c = 0; c < 64; ++c) {
            const int it = (b * 64 + c) * 4 + h;
#pragma unroll
            for (int j = 0; j < 2; ++j) *(v2u*)(CT + ((size_t)it * 128 + 32 * q + 16 * j + (lane & 15)) * 128 + 16 * w + 4 * g) = (v2u){pg8::cvt_pk_bf16(cm[j][0], cm[j][1]), pg8::cvt_pk_bf16(cm[j][2], cm[j][3])};
            *(v2u*)(ST + ((size_t)it * 128 + 32 * q + 16 * (w >> 2) + (lane & 15)) * 64 + 16 * (w & 3) + 4 * g) = (v2u){pg8::cvt_pk_bf16(cgs[0], cgs[1]), pg8::cvt_pk_bf16(cgs[2], cgs[3])};
            if (q == 0) { if (tid < 128) NST[(size_t)it * 128 + tid] = nreg; if (tid == 0) MST[it] = m; }
            if (c == 63) break;
            __syncthreads();
            const bool more = (c + 1) < 63;
            if (more) { const size_t t1 = (size_t)(c + 1) * 64;
                p0 = *(const v4u*)(kwm_g + (t1 + r01) * 512 + c01); p1 = *(const v4u*)(kwm_g + (t1 + r01 + 32) * 512 + c01);
                p2 = *(const v4u*)(kwg_g + (t1 + r2) * 256 + c2); p3 = *(const v4u*)(v_g + (t1 + r3) * NU + c3); }
            const float bL = BLM[it], gmx = GMX[it];
            const f32x4 eb = *(const f32x4*)(EBL + (size_t)(b * 64 + c) * 256 + h * 64 + 16 * (w & 3) + 4 * g);
            const float ksv = (q == 0 && tid < 128) ? KS[(size_t)(b * 64 + c) * 512 + h * 128 + tid] : 0.f;
            const LAS unsigned char* Bf = lds + (c & 1) * BUF;
            f32x4 pm0 = {0.f, 0.f, 0.f, 0.f}, pm1 = {0.f, 0.f, 0.f, 0.f}, pg = {0.f, 0.f, 0.f, 0.f};
#pragma unroll
            for (int ks = 0; ks < 2; ++ks) {
                const bf16x8 xa = frag_t((const LAS bf16*)(Bf + O_KWM), 136, 32 * ks, 16 * w, lane);
                const bf16x8 y0 = frag_t((const LAS bf16*)(Bf + O_VM), 40, 32 * ks, 0, lane), y1 = frag_t((const LAS bf16*)(Bf + O_VM), 40, 32 * ks, 16, lane);
                pm0 = MFMA16(xa, y0, pm0); pm1 = MFMA16(xa, y1, pm1);
                const bf16x8 xg = frag_t((const LAS bf16*)(Bf + O_KWG), 72, 32 * ks, 16 * (w & 3), lane);
                const bf16x8 yg = frag_t((const LAS bf16*)(Bf + O_VG), 40, 32 * ks, 16 * (w >> 2), lane);
                pg = MFMA16(xg, yg, pg);
            }
            const float m_new = fmaxf(bL + m, gmx), decay = __expf(bL + m - m_new), scale2 = __expf(gmx - m_new);
            cm[0] = cm[0] * decay + pm0 * scale2; cm[1] = cm[1] * decay + pm1 * scale2;
            cgs = cgs * eb + pg;
            nreg = nreg * decay + ksv * scale2; m = m_new;
            if (more) { LAS unsigned char* Bn = lds + ((c + 1) & 1) * BUF;
                *(LAS v4u*)(Bn + O_KWM + (r01 * 136 + c01) * 2) = p0; *(LAS v4u*)(Bn + O_KWM + ((r01 + 32) * 136 + c01) * 2) = p1;
                *(LAS v4u*)(Bn + O_KWG + (r2 * 72 + c2) * 2) = p2; *(LAS v4u*)(Bn + (tid < 256 ? O_VM : O_VG) + (r3 * 40 + c3) * 2) = p3; }
        }
        __syncthreads();
    }
}

__device__ __forceinline__ void mlstm_item(LAS unsigned char* lds, int b, int c, int h, const bf16* QM, const bf16* KM, const bf16* U, const float* LI, const float* BF,
                                           const bf16* CT, const float* NST, const float* MST, const float* gnorm, bf16* HM) {
    const int tid = threadIdx.x, lane = tid & 63, w = __builtin_amdgcn_readfirstlane(tid >> 6), g = lane >> 4;
    LAS bf16* Qs = (LAS bf16*)lds;
    LAS bf16* Ks = (LAS bf16*)(lds + 17408);
    LAS bf16* Vs = (LAS bf16*)(lds + 34816);
    LAS bf16* Cts = (LAS bf16*)(lds + 54272);
    LAS bf16* Sp = (LAS bf16*)(lds + 93440);
    LAS float* bs = (LAS float*)(lds + 102656); LAS float* lis = bs + 64; LAS float* mts = lis + 64; LAS float* wis = mts + 64;
    LAS float* H = (LAS float*)lds;
    const size_t t0 = (size_t)b * SEQ + (size_t)c * 64; const int it = (b * 64 + c) * 4 + h;
    for (int i = tid; i < 1024; i += 512) { const int t = i >> 4, cc = (i & 15) * 8;
        *(LAS v4u*)(Qs + t * 136 + cc) = *(const v4u*)(QM + (t0 + t) * 512 + h * 128 + cc);
        *(LAS v4u*)(Ks + t * 136 + cc) = *(const v4u*)(KM + (t0 + t) * 512 + h * 128 + cc);
        *(LAS v4u*)(Vs + t * 152 + cc) = *(const v4u*)(U + (t0 + t) * NU + 1024 + h * 128 + cc); }
    for (int i = tid; i < 2048; i += 512) { const int e = i >> 4, cc = (i & 15) * 8; *(LAS v4u*)(Cts + e * 136 + cc) = *(const v4u*)(CT + ((size_t)it * 128 + e) * 128 + cc); }
    if (tid < 64) { *(LAS v4u*)(Vs + tid * 152 + 128) = (v4u){0x00003F80u, 0u, 0u, 0u}; *(LAS v4u*)(Vs + tid * 152 + 136) = (v4u){0u, 0u, 0u, 0u};
        bs[tid] = BF[(t0 + tid) * 4 + h]; lis[tid] = LI[(t0 + tid) * 4 + h]; }
    if (tid < 128) Cts[128 * 136 + tid] = (bf16)f2bf(NST[(size_t)it * 128 + tid]);
    for (int i = tid; i < 15 * 16; i += 512) { const int e = 129 + (i >> 4), cc = (i & 15) * 8; *(LAS v4u*)(Cts + e * 136 + cc) = (v4u){0u, 0u, 0u, 0u}; }
    const float m_c = MST[it];
    __syncthreads();
    if (tid < 64) { const int t = tid; float mx = -3.0e38f;
        for (int s = 0; s <= t; ++s) mx = fmaxf(mx, lis[s] - bs[s]);
        const float bt = bs[t], mt = bt + fmaxf(mx, m_c); mts[t] = mt; wis[t] = __expf(bt + m_c - mt); }
    f32x4 sa[2] = {{0.f, 0.f, 0.f, 0.f}, {0.f, 0.f, 0.f, 0.f}};
    const int tt = w >> 1, si0 = 2 * (w & 1);
#pragma unroll
    for (int ks = 0; ks < 4; ++ks) { const bf16x8 y = frag_n(Qs, 136, 16 * tt, 32 * ks, lane);
#pragma unroll
        for (int j = 0; j < 2; ++j) sa[j] = MFMA16(frag_n(Ks, 136, 16 * (si0 + j), 32 * ks, lane), y, sa[j]); }
    __syncthreads();
    { const int t = 16 * tt + (lane & 15); const float bt = bs[t], mt = mts[t];
#pragma unroll
        for (int j = 0; j < 2; ++j) { const int s0 = 16 * (si0 + j) + 4 * g; float v[4];
#pragma unroll
            for (int r = 0; r < 4; ++r) { const int s = s0 + r; v[r] = (s <= t) ? sa[j][r] * __expf(bt - bs[s] + lis[s] - mt) : 0.f; }
            *(LAS v2u*)(Sp + t * 72 + s0) = (v2u){pg8::cvt_pk_bf16(v[0], v[1]), pg8::cvt_pk_bf16(v[2], v[3])}; } }
    __syncthreads();
    f32x4 a1[5], a2[5];
#pragma unroll
    for (int j = 0; j < 5; ++j) { a1[j] = (f32x4){0.f, 0.f, 0.f, 0.f}; a2[j] = (f32x4){0.f, 0.f, 0.f, 0.f}; }
    const int t2 = w & 3, e0 = (w >> 2) * 5, ne = (w >> 2) ? 4 : 5;
#pragma unroll
    for (int ks = 0; ks < 2; ++ks) { const bf16x8 y = frag_n(Sp, 72, 16 * t2, 32 * ks, lane);
#pragma unroll
        for (int j = 0; j < 5; ++j) if (j < ne) a1[j] = MFMA16(frag_t(Vs, 152, 32 * ks, 16 * (e0 + j), lane), y, a1[j]); }
#pragma unroll
    for (int ks = 0; ks < 4; ++ks) { const bf16x8 y = frag_n(Qs, 136, 16 * t2, 32 * ks, lane);
#pragma unroll
        for (int j = 0; j < 5; ++j) if (j < ne) a2[j] = MFMA16(frag_n(Cts, 136, 16 * (e0 + j), 32 * ks, lane), y, a2[j]); }
    __syncthreads();
    { const int t = 16 * t2 + (lane & 15); const float wi = wis[t];
#pragma unroll
        for (int j = 0; j < 5; ++j) if (j < ne) *(LAS f32x4*)(H + t * 148 + 16 * (e0 + j) + 4 * g) = a1[j] + a2[j] * wi; }
    __syncthreads();
    { const int t = tid >> 3, j = tid & 7; const float den = H[t * 148 + 128], dinv = 1.0f / fmaxf(fabsf(den), __expf(-mts[t]));
        float vals[16], mo[16]; float ss = 0.f;
#pragma unroll
        for (int k = 0; k < 4; ++k) { const f32x4 v = *(const LAS f32x4*)(H + t * 148 + 16 * j + 4 * k); vals[4 * k] = v[0] * dinv; vals[4 * k + 1] = v[1] * dinv; vals[4 * k + 2] = v[2] * dinv; vals[4 * k + 3] = v[3] * dinv; }
#pragma unroll
        for (int k = 0; k < 16; ++k) ss += vals[k] * vals[k];
        ss += __shfl_xor(ss, 1); ss += __shfl_xor(ss, 2); ss += __shfl_xor(ss, 4);
        const float rstd = 1.0f / sqrtf(ss * (1.0f / 128.0f) + EPS);
        const int col = h * 128 + 16 * j;
        { float t8[8]; unpack8(*(const v4u*)(U + (t0 + t) * NU + 1536 + col), t8);
#pragma unroll
          for (int k = 0; k < 8; ++k) mo[k] = t8[k];
          unpack8(*(const v4u*)(U + (t0 + t) * NU + 1536 + col + 8), t8);
#pragma unroll
          for (int k = 0; k < 8; ++k) mo[8 + k] = t8[k]; }
        float o[16];
#pragma unroll
        for (int k = 0; k < 16; ++k) o[k] = vals[k] * rstd * gnorm[col + k] / (1.0f + __expf(-mo[k]));
        float o0[8], o1[8];
#pragma unroll
        for (int k = 0; k < 8; ++k) { o0[k] = o[k]; o1[k] = o[8 + k]; }
        *(v4u*)(HM + (t0 + t) * 1024 + col) = pack8(o0); *(v4u*)(HM + (t0 + t) * 1024 + col + 8) = pack8(o1); }
    __syncthreads();
}
__device__ __forceinline__ void gla_item(LAS unsigned char* lds, int b, int c, int h, const bf16* QG, const bf16* KG, const bf16* U, const bf16* ST, const float* gnorm, bf16* HM) {
    const int tid = threadIdx.x, lane = tid & 63, w = __builtin_amdgcn_readfirstlane(tid >> 6), g = lane >> 4;
    LAS bf16* Qg = (LAS bf16*)lds;
    LAS bf16* Kg = (LAS bf16*)(lds + 9216);
    LAS bf16* Vs = (LAS bf16*)(lds + 18432);
    LAS bf16* Sts = (LAS bf16*)(lds + 35840);
    LAS bf16* Ap = (LAS bf16*)(lds + 54272);
    LAS float* H = (LAS float*)(lds + 64512);
    const size_t t0 = (size_t)b * SEQ + (size_t)c * 64; const int it = (b * 64 + c) * 4 + h;
    { const int t = tid >> 3, cc = (tid & 7) * 8;
        *(LAS v4u*)(Qg + t * 72 + cc) = *(const v4u*)(QG + (t0 + t) * 256 + h * 64 + cc);
        *(LAS v4u*)(Kg + t * 72 + cc) = *(const v4u*)(KG + (t0 + t) * 256 + h * 64 + cc); }
    for (int i = tid; i < 1024; i += 512) { const int t = i >> 4, cc = (i & 15) * 8; *(LAS v4u*)(Vs + t * 136 + cc) = *(const v4u*)(U + (t0 + t) * NU + 2560 + h * 128 + cc); }
    for (int i = tid; i < 1024; i += 512) { const int e = i >> 3, cc = (i & 7) * 8; *(LAS v4u*)(Sts + e * 72 + cc) = *(const v4u*)(ST + ((size_t)it * 128 + e) * 64 + cc); }
    __syncthreads();
    f32x4 sa[2] = {{0.f, 0.f, 0.f, 0.f}, {0.f, 0.f, 0.f, 0.f}};
    const int tt = w >> 1, si0 = 2 * (w & 1);
#pragma unroll
    for (int ks = 0; ks < 2; ++ks) { const bf16x8 y = frag_n(Qg, 72, 16 * tt, 32 * ks, lane);
#pragma unroll
        for (int j = 0; j < 2; ++j) sa[j] = MFMA16(frag_n(Kg, 72, 16 * (si0 + j), 32 * ks, lane), y, sa[j]); }
    { const int t = 16 * tt + (lane & 15);
#pragma unroll
        for (int j = 0; j < 2; ++j) { const int s0 = 16 * (si0 + j) + 4 * g; float v[4];
#pragma unroll
            for (int r = 0; r < 4; ++r) v[r] = (s0 + r <= t) ? sa[j][r] : 0.f;
            *(LAS v2u*)(Ap + t * 72 + s0) = (v2u){pg8::cvt_pk_bf16(v[0], v[1]), pg8::cvt_pk_bf16(v[2], v[3])}; } }
    __syncthreads();
    f32x4 ac[4];
#pragma unroll
    for (int j = 0; j < 4; ++j) ac[j] = (f32x4){0.f, 0.f, 0.f, 0.f};
    const int t2 = w & 3, e0 = (w >> 2) * 4;
#pragma unroll
    for (int ks = 0; ks < 2; ++ks) { const bf16x8 y = frag_n(Ap, 72, 16 * t2, 32 * ks, lane);
#pragma unroll
        for (int j = 0; j < 4; ++j) ac[j] = MFMA16(frag_t(Vs, 136, 32 * ks, 16 * (e0 + j), lane), y, ac[j]); }
#pragma unroll
    for (int ks = 0; ks < 2; ++ks) { const bf16x8 y = frag_n(Qg, 72, 16 * t2, 32 * ks, lane);
#pragma unroll
        for (int j = 0; j < 4; ++j) ac[j] = MFMA16(frag_n(Sts, 72, 16 * (e0 + j), 32 * ks, lane), y, ac[j]); }
    { const int t = 16 * t2 + (lane & 15);
#pragma unroll
        for (int j = 0; j < 4; ++j) *(LAS f32x4*)(H + t * 148 + 16 * (e0 + j) + 4 * g) = ac[j]; }
    __syncthreads();
    { const int t = tid >> 3, j = tid & 7; float vals[16], gr[16]; float ss = 0.f;
#pragma unroll
        for (int k = 0; k < 4; ++k) { const f32x4 v = *(const LAS f32x4*)(H + t * 148 + 16 * j + 4 * k); vals[4 * k] = v[0]; vals[4 * k + 1] = v[1]; vals[4 * k + 2] = v[2]; vals[4 * k + 3] = v[3]; }
#pragma unroll
        for (int k = 0; k < 16; ++k) ss += vals[k] * vals[k];
        ss += __shfl_xor(ss, 1); ss += __shfl_xor(ss, 2); ss += __shfl_xor(ss, 4);
        const float rstd = 1.0f / sqrtf(ss * (1.0f / 128.0f) + EPS);
        const int col = h * 128 + 16 * j;
        { float t8[8]; unpack8(*(const v4u*)(U + (t0 + t) * NU + 3072 + col), t8);
#pragma unroll
          for (int k = 0; k < 8; ++k) gr[k] = t8[k];
          unpack8(*(const v4u*)(U + (t0 + t) * NU + 3072 + col + 8), t8);
#pragma unroll
          for (int k = 0; k < 8; ++k) gr[8 + k] = t8[k]; }
        float o0[8], o1[8];
#pragma unroll
        for (int k = 0; k < 8; ++k) { o0[k] = vals[k] * rstd * gnorm[col + k] * gr[k] / (1.0f + __expf(-gr[k])); o1[k] = vals[8 + k] * rstd * gnorm[col + 8 + k] * gr[8 + k] / (1.0f + __expf(-gr[8 + k])); }
        *(v4u*)(HM + (t0 + t) * 1024 + 512 + col) = pack8(o0); *(v4u*)(HM + (t0 + t) * 1024 + 512 + col + 8) = pack8(o1); }
    __syncthreads();
}
__device__ __forceinline__ void phase_mixout(const Args& a, LAS unsigned char* lds, int G) {
    unsigned char* ws = a.ws;
    for (int i = blockIdx.x; i < 8192; i += G) {
        const int mode = i >> 12, r = i & 4095, h = r & 3, bc = r >> 2, b = bc >> 6, c = bc & 63;
        if (mode == 0) mlstm_item(lds, b, c, h, (const bf16*)(ws + WS_QM), (const bf16*)(ws + WS_KM), (const bf16*)(ws + WS_U), (const float*)(ws + WS_LI), (const float*)(ws + WS_BF),
                                  (const bf16*)(ws + WS_CT), (const float*)(ws + WS_NST), (const float*)(ws + WS_MST), a.in[I_MNG], (bf16*)(ws + WS_HM));
        else gla_item(lds, b, c, h, (const bf16*)(ws + WS_QG), (const bf16*)(ws + WS_KG), (const bf16*)(ws + WS_U), (const bf16*)((const unsigned char*)a.out + DO_ST), a.in[I_GNG], (bf16*)(ws + WS_HM));
    }
}

#ifndef MK_N_LAUNCHES
#define MK_N_LAUNCHES 1
#endif
constexpr int NPHASES = 14;
__global__ void __launch_bounds__(NWAVES * 64, 2) fwd_kernel(Args args) {
    extern __shared__ __attribute__((aligned(16))) unsigned char lds_raw[];
    LAS unsigned char* lds = (LAS unsigned char*)lds_raw;
    const int tid = threadIdx.x, G = gridDim.x, bid = blockIdx.x;
    unsigned char* ws = args.ws;
    volatile LAS unsigned* MISC = (volatile LAS unsigned*)(lds + MISC_OFF);
    for (int u = tid; u < (LDS_BYTES - MISC_OFF) / 4; u += NWAVES * 64) ((LAS unsigned*)(lds + MISC_OFF))[u] = 0u;
    __syncthreads();
    XcdBarrier bar; bar.bar = (unsigned*)(ws + WS_CTL) + CW_BAR; bar.x = 0; bar.st = nullptr;
    if (MK_N_LAUNCHES == 1) bar = xcd_barrier_post((unsigned*)(ws + WS_CTL) + CW_BAR, MISC + 8);
    const int lo = args.ph_lo, hi = args.ph_hi;
#ifndef PH_MASK
#define PH_MASK 0x3fff
#endif
#define IN(k) (((PH_MASK >> (k)) & 1) && lo <= (k) && (k) < hi)
#define SEAM(k) do { if (IN(k) && IN((k) + 1)) xcd_barrier(bar); } while (0)
    using namespace pg8;
    const bf16_t* XB = (const bf16_t*)(ws + WS_XB);
    if (IN(0)) { phase_prologue(args, lds, G); SEAM(0); }
    if (IN(1)) {
        { Gemm g{XB, (const bf16_t*)(ws + WS_WIN), 1024, 1024, 1024}; StaticOrder S; S.init(T, NINP, G, bid);
          typedef Epi<1, 0, 0, 0, 0, 1> E_t; E_t E{(void*)(ws + WS_U), NU, (const float*)(ws + WS_RSTD0), 1.f, nullptr, nullptr, (float*)(ws + WS_GATES)};
          gemm_phase<E_t, StaticOrder, true, true>(lds, g, S, E); }
        { Gemm g{(const bf16_t*)(ws + WS_MEMN), (const bf16_t*)(ws + WS_WK), 1024, 1024, 1024}; StaticOrder S; S.init(TMEM, 1024, G, bid);
          typedef Epi<0, 0, 0, 0, 0, 0> E_t; E_t E{(void*)(ws + WS_KB), 1024, nullptr, 1.f, nullptr, nullptr, nullptr};
          gemm_phase<E_t, StaticOrder, true, true>(lds, g, S, E); }
        { Gemm g{(const bf16_t*)(ws + WS_WV), (const bf16_t*)(ws + WS_MEMN), 1024, 1024, 1024}; StaticOrder S; S.init(1024, TMEM, G, bid);
          typedef Epi<0, 0, 0, 0, 0, 0> E_t; E_t E{(void*)(ws + WS_VT), 4096, nullptr, 1.f, nullptr, nullptr, nullptr};
          gemm_phase<E_t, StaticOrder, true, true>(lds, g, S, E); }
        SEAM(1);
    }
    if (IN(2)) { phase_prep(args, lds, G); SEAM(2); }
    if (IN(3)) { phase_chain(args, lds, G); SEAM(3); }
    if (IN(4)) { phase_mixout(args, lds, G); SEAM(4); }
    if (IN(5)) {
        Gemm g{(const bf16_t*)(ws + WS_HM), (const bf16_t*)(ws + WS_WOUT), 1024, 1024, 1024}; StaticOrder S; S.init(T, 1024, G, bid);
        typedef Epi<0, 0, 1, 0, 1, 0> E_t; E_t E{(void*)(ws + WS_X1), 1024, nullptr, 1.f, (const void*)args.in[I_X], (float*)(ws + WS_SSP1), nullptr};
        gemm_phase<E_t, StaticOrder, true, true>(lds, g, S, E); SEAM(5);
    }
    if (IN(6)) {
        Gemm g{(const bf16_t*)(ws + WS_X1), (const bf16_t*)(ws + WS_WQ), 1024, 1024, 1024}; StaticOrder S; S.init(T, 1024, G, bid);
        typedef Epi<2, 0, 0, 0, 0, 0> E_t; E_t E{(void*)(ws + WS_HQ), 1024, (const float*)(ws + WS_SSP1), 0.0625f, nullptr, nullptr, nullptr};
        gemm_phase<E_t, StaticOrder, true, true>(lds, g, S, E); SEAM(6);
    }
    if (IN(7)) {
        Gemm g{(const bf16_t*)(ws + WS_HQ), (const bf16_t*)(ws + WS_KB), 1024, 1024, 256}; AttnOrder<0> S{G, bid};
        typedef Epi<0, 0, 0, 1, 0, 0> E_t; E_t E{(void*)args.out, 1024, nullptr, 1.f, nullptr, nullptr, nullptr};
        gemm_phase<E_t, AttnOrder<0>, true, true>(lds, g, S, E); SEAM(7);
    }
    if (IN(8)) { phase_softmax(args.out, (bf16*)(ws + WS_P), G); SEAM(8); }
    if (IN(9)) {
        Gemm g{(const bf16_t*)(ws + WS_P), (const bf16_t*)(ws + WS_VT), 1024, 4096, 256}; AttnOrder<1> S{G, bid};
        typedef Epi<0, 0, 0, 0, 0, 0> E_t; E_t E{(void*)(ws + WS_ATT), 1024, nullptr, 1.f, nullptr, nullptr, nullptr};
        gemm_phase<E_t, AttnOrder<1>, true, true>(lds, g, S, E); SEAM(9);
    }
    if (IN(10)) {
        Gemm g{(const bf16_t*)(ws + WS_ATT), (const bf16_t*)(ws + WS_WO), 1024, 1024, 1024}; StaticOrder S; S.init(T, 1024, G, bid);
        typedef Epi<0, 0, 2, 0, 1, 0> E_t; E_t E{(void*)(ws + WS_X2), 1024, nullptr, 1.f, (const void*)(ws + WS_X1), (float*)(ws + WS_SSP2), nullptr};
        gemm_phase<E_t, StaticOrder, true, true>(lds, g, S, E); SEAM(10);
    }
    if (IN(11)) {
        Gemm g{(const bf16_t*)(ws + WS_X2), (const bf16_t*)(ws + WS_W1), 1024, 1024, 1024}; StaticOrder S; S.init(T, DFF, G, bid);
        typedef Epi<2, 1, 0, 0, 0, 0> E_t; E_t E{(void*)(ws + WS_HID), DFF, (const float*)(ws + WS_SSP2), 1.f, nullptr, nullptr, nullptr};
        gemm_phase<E_t, StaticOrder, true, true>(lds, g, S, E); SEAM(11);
    }
    if (IN(12)) {
        Gemm g{(const bf16_t*)(ws + WS_HID), (const bf16_t*)(ws + WS_W2), DFF, DFF, DFF}; StaticOrder S; S.init(T, 1024, G, bid);
        typedef Epi<0, 0, 2, 1, 1, 0> E_t; E_t E{(void*)args.out, 1024, nullptr, 1.f, (const void*)(ws + WS_X2), (float*)(ws + WS_SSP3), nullptr};
        gemm_phase<E_t, StaticOrder, true, true>(lds, g, S, E); SEAM(12);
    }
    if (IN(13)) phase_final(args.out, (const float*)(ws + WS_SSP3), args.in[I_FING], G);
#undef IN
#undef SEAM
}

extern "C" void kernel_launch(void* const* d_in, const int* in_sizes, int n_in, void* d_out, int out_size, void* d_ws, size_t ws_size, hipStream_t stream) {
    static int grid = 0;
    if (grid == 0) {
        if (n_in != 23 || in_sizes[0] != T * DM || out_size != T * DM || ws_size < WS_END) { fprintf(stderr, "kernel_launch: unexpected shapes (n_in %d, in0 %d, out %d, ws %zu); nothing launched\n", n_in, n_in > 0 ? in_sizes[0] : -1, out_size, ws_size); grid = -1; return; }
        int dev = 0, cus = 0;
        if (hipGetDevice(&dev) != hipSuccess || hipDeviceGetAttribute(&cus, hipDeviceAttributeMultiprocessorCount, dev) != hipSuccess) { grid = -1; return; }
        if (hipFuncSetAttribute((const void*)fwd_kernel, hipFuncAttributeMaxDynamicSharedMemorySize, LDS_BYTES) != hipSuccess) { fprintf(stderr, "kernel_launch: hipFuncSetAttribute failed\n"); grid = -1; return; }
        int per_cu = 0;
        if (hipOccupancyMaxActiveBlocksPerMultiprocessor(&per_cu, (const void*)fwd_kernel, NWAVES * 64, LDS_BYTES) != hipSuccess || per_cu < 1) fprintf(stderr, "kernel_launch: occupancy query reports %d\n", per_cu);
        (void)hipGetLastError();
        grid = cus;
    }
    if (grid < 0) return;
    (void)hipMemsetAsync((char*)d_ws + WS_CTL, 0, CTL_ZERO_BYTES, stream);
    Args a{};
    for (int i = 0; i < 23; ++i) a.in[i] = (const float*)d_in[i];
    a.out = (float*)d_out; a.ws = (unsigned char*)d_ws;
    if (MK_N_LAUNCHES == 1) { a.ph_lo = 0; a.ph_hi = NPHASES; hipLaunchKernelGGL(fwd_kernel, dim3(grid), dim3(NWAVES * 64), LDS_BYTES, stream, a); }
    else for (int p = 0; p < NPHASES; ++p) { a.ph_lo = p; a.ph_hi = p + 1; hipLaunchKernelGGL(fwd_kernel, dim3(grid), dim3(NWAVES * 64), LDS_BYTES, stream, a); }
}
```

```cpp
#include <hip/hip_runtime.h>
#include <cstdio>
#include <cstdint>
namespace pg8 {
#define PG8_LAS __attribute__((address_space(3)))
typedef unsigned short bf16_t;
typedef short bf16x8 __attribute__((ext_vector_type(8)));
typedef float f32x4 __attribute__((ext_vector_type(4)));
typedef unsigned u32x4 __attribute__((ext_vector_type(4)));
constexpr int BM = 256, BK = 64, HALF = 128, HTB = HALF * BK * 2  , STAGE_BYTES = 8 * HTB, NXCD = 8, WGM = 8;

__host__ __device__ __forceinline__ int lds_byte(int r, int c) { const int st = (r >> 4) * 2 + (c >> 5), rr = r & 15, cc = c & 31, ob = rr * 64 + cc * 2; return st * 1024 + (ob ^ (((ob >> 9) & 1) << 5)); }
__host__ __device__ __forceinline__ void stage_rc(int b, int& R, int& C) { const int st = b / 1024, sb = b % 1024, swz = sb ^ (((sb >> 9) & 1) << 5); R = (st >> 1) * 16 + swz / 64; C = (st & 1) * 32 + (swz % 64) / 2; }
__host__ __device__ __forceinline__ int perm32(int rho) { const int n = rho >> 4, i = rho & 15; return 8 * (i >> 2) + 4 * n + (i & 3); }


struct Unit { int pm, pn; };
struct Gemm { const bf16_t* A; const bf16_t* Bt; int lda, ldb, K; };

struct StaticOrder {
    int nM, nN, nwg, G, c;
    __host__ __device__ void init(int M, int N, int G_, int c_) { nM = M / BM; nN = N / BM; nwg = nM * nN; G = G_; c = c_; }
    __host__ __device__ bool next(int i, Unit& u) const {
        const long L = (long)i * G + c; if (L >= nwg) return false;
        int wgid = (int)L; { const int q = nwg / NXCD, r = nwg % NXCD, xcd = wgid % NXCD, off = wgid / NXCD; wgid = (xcd < r ? xcd * (q + 1) : r * (q + 1) + (xcd - r) * q) + off; }
        const int nig = WGM * nN, gid = wgid / nig, fm = gid * WGM, gsz = (nM - fm) < WGM ? (nM - fm) : WGM;
        u.pm = fm + ((wgid % nig) % gsz); u.pn = (wgid % nig) / gsz; return true;
    }
    __device__ __forceinline__ const char* aptr(const Gemm& g, const Unit& u) const { return (const char*)g.A + (size_t)u.pm * BM * g.lda * 2; }
    __device__ __forceinline__ const char* bptr(const Gemm& g, const Unit& u) const { return (const char*)g.Bt + (size_t)u.pn * BM * g.ldb * 2; }
    __device__ __forceinline__ void a_ready(const Unit&) const {}
    __device__ __forceinline__ void done(const Unit&) const {}
};
template <int MODE> struct AttnOrder {
    int G, c;
    __device__ bool next(int i, Unit& u) const { const long L = (long)i * G + c; if (L >= 1024) return false; u.pm = (int)(L >> 2); u.pn = (int)(L & 3); return true; }
    __device__ __forceinline__ const char* aptr(const Gemm& g, const Unit& u) const { return (const char*)g.A + ((size_t)u.pm * 256 * 1024 + (size_t)u.pn * 256) * 2; }
    __device__ __forceinline__ const char* bptr(const Gemm& g, const Unit& u) const {
        return MODE == 0 ? (const char*)g.Bt + ((size_t)(u.pm >> 4) * 256 * 1024 + (size_t)u.pn * 256) * 2
                         : (const char*)g.Bt + ((size_t)u.pn * 256 * 4096 + (size_t)(u.pm >> 4) * 256) * 2; }
    __device__ __forceinline__ void a_ready(const Unit&) const {}
    __device__ __forceinline__ void done(const Unit&) const {}
};

__device__ __forceinline__ unsigned cvt_pk_bf16(float lo, float hi) { unsigned r; asm volatile("v_cvt_pk_bf16_f32 %0, %1, %2" : "=v"(r) : "v"(lo), "v"(hi)); return r; }
__device__ __forceinline__ float bf_lo(unsigned w) { return __uint_as_float(w << 16); }
__device__ __forceinline__ float bf_hi(unsigned w) { return __uint_as_float(w & 0xffff0000u); }

template <int RS  , int ACT, int RES, int OUTF32, int SSQ, int GATE>
struct Epi {
    static constexpr bool PERM = true, AFTER_DRAIN = false;
    void* out; int ldc; const float* rs; float scale; const void* base; float* ssp; float* gates;
    __device__ __forceinline__ void operator()(const f32x4 (&acc)[2][2][4][2], const Unit& u, int wr, int wc, int fr, int fq) const {
        const int row0 = u.pm * BM + wr * 64 + fr, col0 = u.pn * BM + wc * 32 + 8 * fq;
        const bool gate_tile = GATE && (u.pn == 14);
#pragma unroll
        for (int ai = 0; ai < 2; ++ai)
#pragma unroll
            for (int m = 0; m < 4; ++m) {
                const int r = row0 + ai * HALF + m * 16;
                float rsv = scale;
                if (RS == 1) rsv *= rs[r];
                if (RS == 2) { const f32x4* p = (const f32x4*)(rs + (size_t)r * 16); const f32x4 a = p[0], b = p[1], c = p[2], d = p[3];
                    const float s = ((a[0] + a[1]) + (a[2] + a[3])) + ((b[0] + b[1]) + (b[2] + b[3])) + ((c[0] + c[1]) + (c[2] + c[3])) + ((d[0] + d[1]) + (d[2] + d[3]));
                    rsv *= 1.0f / sqrtf(s * (1.0f / 1024.0f) + 1e-6f); }
                float ss = 0.f;
#pragma unroll
                for (int bj = 0; bj < 2; ++bj) {
                    f32x4 v0 = acc[ai][bj][m][0] * rsv, v1 = acc[ai][bj][m][1] * rsv;
                    if (ACT == 1) { v0 = __builtin_elementwise_max(v0, (f32x4){0.f, 0.f, 0.f, 0.f}); v1 = __builtin_elementwise_max(v1, (f32x4){0.f, 0.f, 0.f, 0.f}); v0 = v0 * v0; v1 = v1 * v1; }
                    const size_t off = (size_t)r * ldc + col0 + bj * HALF;
                    if (RES == 1) { const f32x4* bp = (const f32x4*)((const float*)base + off); v0 = v0 + bp[0]; v1 = v1 + bp[1]; }
                    if (RES == 2) { const u32x4 w = *(const u32x4*)((const bf16_t*)base + off);
                        v0 = v0 + (f32x4){bf_lo(w.x), bf_hi(w.x), bf_lo(w.y), bf_hi(w.y)}; v1 = v1 + (f32x4){bf_lo(w.z), bf_hi(w.z), bf_lo(w.w), bf_hi(w.w)}; }
                    if (SSQ) ss += ((v0[0] * v0[0] + v0[1] * v0[1]) + (v0[2] * v0[2] + v0[3] * v0[3])) + ((v1[0] * v1[0] + v1[1] * v1[1]) + (v1[2] * v1[2] + v1[3] * v1[3]));
                    if (gate_tile) { if (bj == 0 && wc == 0 && fq < 3) { f32x4* gp = (f32x4*)(gates + (size_t)r * 32 + 8 * fq); gp[0] = v0; gp[1] = v1; } }
                    else if (OUTF32) { f32x4* op = (f32x4*)((float*)out + off); op[0] = v0; op[1] = v1; }
                    else { u32x4 w; w.x = cvt_pk_bf16(v0[0], v0[1]); w.y = cvt_pk_bf16(v0[2], v0[3]); w.z = cvt_pk_bf16(v1[0], v1[1]); w.w = cvt_pk_bf16(v1[2], v1[3]);
                        *(u32x4*)((bf16_t*)out + off) = w; }
                }
                if (SSQ) { ss += __shfl_xor(ss, 16); ss += __shfl_xor(ss, 32); if (fq == 0) ssp[(size_t)r * 16 + u.pn * 4 + wc] = ss; }
                if (RS == 2 || RES != 0) asm volatile("" ::: "memory");
            }
    }
};

template <class Epi, class Sched, bool ALIGN_EPI = false, bool SP2 = false>
__device__ __forceinline__ void gemm_phase(PG8_LAS unsigned char* lds, const Gemm g, const Sched& S, const Epi& E) {
    const int tid = threadIdx.x, wid = __builtin_amdgcn_readfirstlane(tid >> 6), lane = tid & 63, wr = wid >> 2, wc = wid & 3, fr = lane & 15, fq = lane >> 4;
    const int K = g.K, nt = K / BK;
    unsigned voffA[2], voffB[2];
#pragma unroll
    for (int i = 0; i < 2; ++i) { int R, C; stage_rc(tid * 16 + i * 8192, R, C); const int Rb = Epi::PERM ? ((R & ~31) + perm32(R & 31)) : R;
        voffA[i] = (unsigned)(R * g.lda + C) * 2u; voffB[i] = (unsigned)(Rb * g.ldb + C) * 2u; }
    const size_t kstep = (size_t)(BK * 2);
    const size_t hstepA = (size_t)HALF * g.lda * 2, hstepB = (size_t)HALF * g.ldb * 2;
    const unsigned ldsw = (unsigned)wid * 1024u;
    const int aoff = lds_byte(wr * 64 + fr, fq * 8), boff = lds_byte(wc * 32 + fr, fq * 8);
#define PG8_SA(b, h) (((b) * 2 + (h)) * HTB)
#define PG8_SB(b, h) ((4 + (b) * 2 + (h)) * HTB)
#define PG8_STAGE(bufoff, gbase, voff) do { _Pragma("unroll") for (int _i = 0; _i < 2; ++_i) \
        __builtin_amdgcn_global_load_lds((const unsigned*)((const char*)(gbase) + (voff)[_i]), (PG8_LAS unsigned*)(lds + (bufoff) + ldsw + _i * 8192), 16, 0, 0); } while (0)
#define PG8_LDA(dst, b, h) do { _Pragma("unroll") for (int m = 0; m < 4; ++m) _Pragma("unroll") for (int k = 0; k < 2; ++k) dst[m][k] = *(const PG8_LAS bf16x8*)(lds + PG8_SA(b, h) + aoff + m * 2048 + k * 1024); } while (0)
#define PG8_LDB(dst, b, h) do { _Pragma("unroll") for (int n = 0; n < 2; ++n) _Pragma("unroll") for (int k = 0; k < 2; ++k) dst[n][k] = *(const PG8_LAS bf16x8*)(lds + PG8_SB(b, h) + boff + n * 2048 + k * 1024); } while (0)
#define PG8_MMA(ai, bj, At, Bt) do { __builtin_amdgcn_s_setprio(1); _Pragma("unroll") for (int m = 0; m < 4; ++m) _Pragma("unroll") for (int n = 0; n < 2; ++n) _Pragma("unroll") for (int k = 0; k < 2; ++k) \
        acc[ai][bj][m][n] = __builtin_amdgcn_mfma_f32_16x16x32_bf16(Bt[n][k], At[m][k], acc[ai][bj][m][n], 0, 0, 0); __builtin_amdgcn_s_setprio(0); } while (0)
#define PG8_WAIT_V(n) asm volatile("s_waitcnt vmcnt(" #n ")" ::: "memory")
#define PG8_WAIT_L(n) asm volatile("s_waitcnt lgkmcnt(" #n ")" ::: "memory")
#define PG8_BAR __builtin_amdgcn_s_barrier()
#define PG8_SCHED __builtin_amdgcn_sched_barrier(0)
    Unit cur, nxt; int ui = 0;
    if (!S.next(0, cur)) return;
    f32x4 acc[2][2][4][2];
#pragma unroll
    for (int a = 0; a < 2; ++a)
#pragma unroll
        for (int b = 0; b < 2; ++b)
#pragma unroll
            for (int m = 0; m < 4; ++m)
#pragma unroll
                for (int n = 0; n < 2; ++n) acc[a][b][m][n] = (f32x4){0.f, 0.f, 0.f, 0.f};
    bf16x8 At[4][2], B0[2][2], B1[2][2];
    const char* cA = S.aptr(g, cur); const char* cB = S.bptr(g, cur);
    S.a_ready(cur);
    if constexpr (SP2) {
        PG8_STAGE(PG8_SB(0, 0), cB, voffB); PG8_STAGE(PG8_SB(0, 1), cB + hstepB, voffB); PG8_STAGE(PG8_SA(0, 0), cA, voffA); PG8_STAGE(PG8_SA(0, 1), cA + hstepA, voffA);
        if (wr == 1) PG8_BAR;
        PG8_WAIT_V(2); PG8_BAR;
        PG8_STAGE(PG8_SB(1, 0), cB + kstep, voffB); PG8_STAGE(PG8_SA(1, 0), cA + kstep, voffA); PG8_STAGE(PG8_SB(1, 1), cB + hstepB + kstep, voffB);
        PG8_WAIT_V(6); PG8_BAR;
    } else {
        PG8_STAGE(PG8_SB(0, 0), cB, voffB); PG8_STAGE(PG8_SA(0, 0), cA, voffA); PG8_STAGE(PG8_SB(0, 1), cB + hstepB, voffB); PG8_STAGE(PG8_SA(0, 1), cA + hstepA, voffA);
        if (wr == 1) PG8_BAR;
        PG8_WAIT_V(4); PG8_BAR;
        PG8_STAGE(PG8_SB(1, 0), cB + kstep, voffB); PG8_STAGE(PG8_SA(1, 0), cA + kstep, voffA); PG8_STAGE(PG8_SB(1, 1), cB + hstepB + kstep, voffB);
        PG8_WAIT_V(6); PG8_BAR;
    }
    for (;;) {
        const bool has_next = S.next(ui + 1, nxt);
        const char* nA = has_next ? S.aptr(g, nxt) : cA; const char* nB = has_next ? S.bptr(g, nxt) : cB;
        _Pragma("unroll 1") for (int t = 0; t < nt; t += 2) {
            const bool last = (t == nt - 2);
            const char* a1 = cA + (size_t)(t + 1) * kstep;
            const char* a2 = last ? nA : cA + (size_t)(t + 2) * kstep; const char* b2 = last ? nB : cB + (size_t)(t + 2) * kstep;
            const char* a3 = a2 + kstep; const char* b3 = b2 + kstep;
            if (last && has_next) S.a_ready(nxt);
            if constexpr (SP2) {
            PG8_LDB(B0, 0, 0); PG8_LDB(B1, 0, 1); PG8_SCHED; PG8_LDA(At, 0, 0); PG8_STAGE(PG8_SA(1, 1), a1 + hstepA, voffA);
            PG8_WAIT_V(8); PG8_WAIT_L(0); PG8_BAR; PG8_MMA(0, 0, At, B0); PG8_MMA(0, 1, At, B1); PG8_BAR; PG8_SCHED;
            PG8_LDA(At, 0, 1); PG8_STAGE(PG8_SB(0, 0), b2, voffB); PG8_STAGE(PG8_SB(0, 1), b2 + hstepB, voffB); PG8_STAGE(PG8_SA(0, 0), a2, voffA);
            PG8_WAIT_V(8); PG8_WAIT_L(0); PG8_BAR; PG8_MMA(1, 0, At, B0); PG8_MMA(1, 1, At, B1); PG8_BAR; PG8_SCHED;
            PG8_LDB(B0, 1, 0); PG8_LDB(B1, 1, 1); PG8_SCHED; PG8_LDA(At, 1, 0); PG8_STAGE(PG8_SA(0, 1), a2 + hstepA, voffA);
            PG8_WAIT_V(8); PG8_WAIT_L(0); PG8_BAR; PG8_MMA(0, 0, At, B0); PG8_MMA(0, 1, At, B1); PG8_BAR; PG8_SCHED;
            PG8_LDA(At, 1, 1); PG8_STAGE(PG8_SB(1, 0), b3, voffB); PG8_STAGE(PG8_SB(1, 1), b3 + hstepB, voffB); PG8_STAGE(PG8_SA(1, 0), a3, voffA);
            PG8_WAIT_V(8); PG8_WAIT_L(0); PG8_BAR; PG8_MMA(1, 0, At, B0); PG8_MMA(1, 1, At, B1); PG8_BAR; PG8_SCHED;
            } else {
            PG8_LDB(B0, 0, 0); PG8_SCHED; PG8_LDA(At, 0, 0); PG8_STAGE(PG8_SA(1, 1), a1 + hstepA, voffA);
            PG8_WAIT_L(8); PG8_BAR; PG8_WAIT_L(0); PG8_MMA(0, 0, At, B0); PG8_BAR; PG8_SCHED;
            PG8_LDB(B1, 0, 1); PG8_STAGE(PG8_SB(0, 0), b2, voffB);
            PG8_BAR; PG8_WAIT_L(0); PG8_MMA(0, 1, At, B1); PG8_BAR;
            PG8_LDA(At, 0, 1); PG8_STAGE(PG8_SA(0, 0), a2, voffA);
            PG8_BAR; PG8_WAIT_L(0); PG8_MMA(1, 0, At, B0); PG8_BAR; PG8_SCHED;
            PG8_STAGE(PG8_SB(0, 1), b2 + hstepB, voffB);
            PG8_WAIT_V(6); PG8_BAR; PG8_MMA(1, 1, At, B1); PG8_BAR;
            PG8_LDB(B0, 1, 0); PG8_SCHED; PG8_LDA(At, 1, 0); PG8_STAGE(PG8_SA(0, 1), a2 + hstepA, voffA);
            PG8_WAIT_L(8); PG8_BAR; PG8_WAIT_L(0); PG8_MMA(0, 0, At, B0); PG8_BAR; PG8_SCHED;
            PG8_LDB(B1, 1, 1); PG8_STAGE(PG8_SB(1, 0), b3, voffB);
            PG8_BAR; PG8_WAIT_L(0); PG8_MMA(0, 1, At, B1); PG8_BAR;
            PG8_LDA(At, 1, 1); PG8_STAGE(PG8_SA(1, 0), a3, voffA);
            PG8_BAR; PG8_WAIT_L(0); PG8_MMA(1, 0, At, B0); PG8_BAR; PG8_SCHED;
            PG8_STAGE(PG8_SB(1, 1), b3 + hstepB, voffB);
            PG8_WAIT_V(6); PG8_BAR; PG8_MMA(1, 1, At, B1); PG8_BAR;
            }
        }
        if constexpr (ALIGN_EPI) { if (wr == 0) PG8_BAR; }
        if constexpr (!Epi::AFTER_DRAIN) { E(acc, cur, wr, wc, fr, fq); S.done(cur); }
        if (!has_next) break;
#pragma unroll
        for (int a = 0; a < 2; ++a)
#pragma unroll
            for (int b = 0; b < 2; ++b)
#pragma unroll
                for (int m = 0; m < 4; ++m)
#pragma unroll
                    for (int n = 0; n < 2; ++n) acc[a][b][m][n] = (f32x4){0.f, 0.f, 0.f, 0.f};
        cur = nxt; cA = nA; cB = nB; ++ui;
        if constexpr (ALIGN_EPI) { if (wr == 1) PG8_BAR; }
    }
    PG8_WAIT_V(0);
    if constexpr (!ALIGN_EPI) { if (wr == 0) PG8_BAR; }
    PG8_BAR;
    if constexpr (Epi::AFTER_DRAIN) { E.fused(acc, cur, wr, wc, fr, fq, lds, wid, lane); S.done(cur); }
#undef PG8_SA
#undef PG8_SB
#undef PG8_STAGE
#undef PG8_LDA
#undef PG8_LDB
#undef PG8_MMA
#undef PG8_WAIT_V
#undef PG8_WAIT_L
#undef PG8_BAR
#undef PG8_SCHED
}
}

constexpr int NWAVES = 8;
constexpr int BATCH = 16, SEQ = 4096, DM = 1024, T = BATCH * SEQ, MEML = 256, TMEM = BATCH * MEML, DFF = 4096, NU = 3584, NINP = 3840;
constexpr float EPS = 1e-6f;
constexpr size_t MiB = 1u << 20;
constexpr size_t WS_CTL = 0, CTL_ZERO_BYTES = 1 * MiB;
constexpr size_t WS_WIN = 2 * MiB, WS_WOUT = 10 * MiB, WS_WQ = 12 * MiB, WS_WK = 14 * MiB, WS_WV = 16 * MiB, WS_WO = 18 * MiB, WS_W1 = 20 * MiB, WS_W2 = 28 * MiB;
constexpr size_t WS_MEMN = 36 * MiB, WS_KB = 44 * MiB, WS_VT = 52 * MiB, WS_RSTD0 = 60 * MiB, WS_SSP1 = 61 * MiB, WS_SSP2 = 65 * MiB, WS_SSP3 = 69 * MiB;
constexpr size_t WS_GATES = 73 * MiB, WS_LI = 81 * MiB, WS_BF = 82 * MiB, WS_EBL = 83 * MiB;
constexpr size_t WS_XB = 96 * MiB, WS_X1 = 96 * MiB, WS_U = 224 * MiB, WS_QM = 672 * MiB, WS_KM = 736 * MiB, WS_QG = 800 * MiB, WS_KG = 832 * MiB, WS_KW = 864 * MiB;
constexpr size_t WS_HM = 896 * MiB, WS_X2 = 896 * MiB, WS_HQ = 224 * MiB, WS_P = 352 * MiB, WS_ATT = 480 * MiB, WS_HID = 224 * MiB, WS_END = 1024 * MiB;
constexpr size_t WS_NST = 84 * MiB, WS_KS = 86 * MiB, WS_MST = 88 * MiB, WS_BLM = 88 * MiB + 65536, WS_GMX = 88 * MiB + 131072, WS_CT = 96 * MiB;
constexpr size_t WS_MXP = 89 * MiB, WS_WG = 90 * MiB;
constexpr size_t DO_KWM = 0, DO_ST = 64 * MiB;
constexpr int CW_BAR = 4096;
constexpr int LDS_BYTES = 163840, MISC_OFF = LDS_BYTES - 512;

#define LAS __attribute__((address_space(3)))
typedef unsigned short bf16;
typedef unsigned v4u __attribute__((ext_vector_type(4)));
typedef unsigned v2u __attribute__((ext_vector_type(2)));
typedef float f32x4 __attribute__((ext_vector_type(4)));
#define LDS_WAIT() asm volatile("s_waitcnt lgkmcnt(0)" ::: "memory")
__device__ __forceinline__ unsigned f2bf(float f) { unsigned u = __builtin_bit_cast(unsigned, f); return (u + 0x7fffu + ((u >> 16) & 1u)) >> 16; }
__device__ __forceinline__ unsigned pk2(float lo, float hi) { return f2bf(lo) | (f2bf(hi) << 16); }
__device__ __forceinline__ float bf2f(bf16 v) { return __uint_as_float((unsigned)v << 16); }
__device__ __forceinline__ float wave_sum(float v) {
#pragma unroll
    for (int o = 1; o < 64; o <<= 1) v += __shfl_xor(v, o);
    return v;
}
__device__ __forceinline__ float wave_max(float v) {
#pragma unroll
    for (int o = 1; o < 64; o <<= 1) v = fmaxf(v, __shfl_xor(v, o));
    return v;
}
__device__ __forceinline__ float logsig(float x) { return fminf(x, 0.f) - log1pf(expf(-fabsf(x))); }

#define XB_TMO      128
#define XB_XCNT(j)  (256  + 64 * (j))
#define XB_XSUB(j)  (1280 + 64 * (j))
#define XB_XGEN(j)  (2304 + 64 * (j))
#define XB_TOP      3328
#define XB_TOPGEN   3392
#define XCD_BAR_WORDS 3456
#define XB_SPIN_CAP (1u << 18)

__device__ __forceinline__ unsigned xb_ld(unsigned* p)              { return __hip_atomic_load(p, __ATOMIC_RELAXED, __HIP_MEMORY_SCOPE_AGENT); }
__device__ __forceinline__ unsigned xb_add(unsigned* p, unsigned v) { return __hip_atomic_fetch_add(p, v, __ATOMIC_RELAXED, __HIP_MEMORY_SCOPE_AGENT); }
__device__ __forceinline__ unsigned xb_xcc_id() { return (unsigned)__builtin_amdgcn_s_getreg((3 << 11) | 20) & 0xFu; }
#define XB_SPIN(cond, bar) do { unsigned _sp = 0; while (cond) { __builtin_amdgcn_s_sleep(1); \
    if ((++_sp & 255u) == 0u) { if (xb_ld(&(bar)[XB_TMO])) break; if (_sp > XB_SPIN_CAP) { atomicAdd(&(bar)[XB_TMO], 1u); break; } } } } while (0)

struct XcdBarrier {
    unsigned* bar; unsigned x;
    volatile LAS unsigned* st;
};

__device__ __forceinline__ XcdBarrier xcd_barrier_post(unsigned* bar, volatile LAS unsigned* st) {
    XcdBarrier b; b.bar = bar; b.x = xb_xcc_id(); b.st = st;
    if (threadIdx.x == 0) (void)xb_add(&bar[XB_XCNT(b.x)], 1u);
    return b;
}
__device__ __forceinline__ void xcd_barrier_complete(unsigned* bar, unsigned x, unsigned& nloc, unsigned& nx) {
    const unsigned G = gridDim.x * gridDim.y * gridDim.z;
    unsigned sum, cnt, mine, sp = 0u;
    for (;;) {
        sum = 0u; cnt = 0u; mine = 0u;
#pragma unroll
        for (unsigned j = 0; j < 16; ++j) { const unsigned c = xb_ld(&bar[XB_XCNT(j)]); sum += c; cnt += (c > 0u) ? 1u : 0u; mine = (j == x) ? c : mine; }
        if (sum == G) break;
        __builtin_amdgcn_s_sleep(1);
        if ((++sp & 255u) == 0u) { if (xb_ld(&bar[XB_TMO])) break; if (sp > XB_SPIN_CAP) { atomicAdd(&bar[XB_TMO], 1u); break; } }
    }
    nloc = mine > 0u ? mine : 1u; nx = cnt > 0u ? cnt : 1u;
}

__device__ __forceinline__ void xcd_barrier(const XcdBarrier& b) {
    asm volatile("s_waitcnt vmcnt(0)" ::: "memory");
    __syncthreads();
    if (threadIdx.x == 0) {
        unsigned* bar = b.bar;
        __builtin_amdgcn_s_waitcnt(0);
        unsigned nloc = b.st[0], nx = b.st[1];
        if (nloc == 0u) { xcd_barrier_complete(bar, b.x, nloc, nx); b.st[0] = nloc; b.st[1] = nx; }
        const unsigned old = xb_add(&bar[XB_XSUB(b.x)], 1u);
        const unsigned gen = old / nloc;
        if (old + 1u == (gen + 1u) * nloc) {
            __builtin_amdgcn_fence(__ATOMIC_RELEASE, "agent");
            asm volatile("s_waitcnt vmcnt(0)" ::: "memory");
            const unsigned og = xb_add(&bar[XB_TOP], 1u);
            const unsigned tg = og / nx;
            if (og + 1u == (tg + 1u) * nx) xb_add(&bar[XB_TOPGEN], 1u);
            else XB_SPIN(xb_ld(&bar[XB_TOPGEN]) == tg, bar);
            __builtin_amdgcn_fence(__ATOMIC_ACQUIRE, "agent");
            xb_add(&bar[XB_XGEN(b.x)], 1u);
            asm volatile("s_waitcnt vmcnt(0)" ::: "memory");
        } else {
            XB_SPIN(xb_ld(&bar[XB_XGEN(b.x)]) == gen, bar);
            __builtin_amdgcn_fence(__ATOMIC_ACQUIRE, "agent");
            asm volatile("s_waitcnt vmcnt(0)" ::: "memory");
        }
    }
    __syncthreads();
}

struct Args { const float* in[23]; float* out; unsigned char* ws; int ph_lo, ph_hi; };
enum { I_X = 0, I_MEM, I_MIXG, I_WIN, I_CONVW, I_CONVB, I_IB, I_FB, I_MNG, I_WA2, I_BA, I_GNG, I_WOUT, I_XAG, I_MEMG, I_WQ, I_WK, I_WV, I_WO, I_MLPG, I_W1, I_W2, I_FING };

__device__ __forceinline__ int map_col(int mode, int nd) {
    if (mode == 0) return nd;
    if (nd < 2048) return nd; if (nd < 3584) return nd + 8; if (nd < 3592) return nd - 3584 + 2048; if (nd < 3608) return nd; return -1;
}
__device__ __forceinline__ void p0_transpose_item(const float* W, int K, int N, const float* gain, bf16* WT, int ndst_blk, int mode, LAS float* scr, int item, int lane) {
    const int kb = item / ndst_blk, nb = item % ndst_blk, k0 = 64 * kb, n0 = 32 * nb;
    const int ns = map_col(mode, n0 + (lane & 31));
#pragma unroll 8
    for (int i = 0; i < 32; ++i) { const int kk = 2 * i + (lane >> 5); float v = 0.f; if (ns >= 0) { v = W[(size_t)(k0 + kk) * N + ns]; if (gain) v *= gain[k0 + kk]; } scr[kk * 33 + (lane & 31)] = v; }
    LDS_WAIT(); asm volatile("" ::: "memory");
    const int c = lane & 7;
#pragma unroll
    for (int j = 0; j < 4; ++j) { const int n = (lane >> 3) + 8 * j; const LAS float* s = scr + (8 * c) * 33 + n;
        v4u o; o.x = pk2(s[0 * 33], s[1 * 33]); o.y = pk2(s[2 * 33], s[3 * 33]); o.z = pk2(s[4 * 33], s[5 * 33]); o.w = pk2(s[6 * 33], s[7 * 33]);
        *(v4u*)(WT + (size_t)(n0 + n) * K + k0 + 8 * c) = o; }
    LDS_WAIT(); asm volatile("" ::: "memory");
}

__device__ __forceinline__ void phase_prologue(const Args& a, LAS unsigned char* lds, int G) {
    const int tid = threadIdx.x, lane = tid & 63, wave = tid >> 6;
    unsigned char* ws = a.ws;
    LAS float* scr = (LAS float*)(lds + wave * 16384);
    const int gw = blockIdx.x * NWAVES + wave, NGW = G * NWAVES;
    constexpr int I_IN = 16 * 120, I_SQ = 16 * 32, I_1 = 16 * 128, I_2 = 64 * 32;
    constexpr int NITEMS = I_IN + 5 * I_SQ + I_1 + I_2;
    for (int it = gw; it < NITEMS; it += NGW) {
        int r = it;
        if (r < I_IN) { p0_transpose_item(a.in[I_WIN], 1024, 3608, a.in[I_MIXG], (bf16*)(ws + WS_WIN), 120, 1, scr, r, lane); continue; } r -= I_IN;
        if (r < I_SQ) { p0_transpose_item(a.in[I_WOUT], 1024, 1024, nullptr, (bf16*)(ws + WS_WOUT), 32, 0, scr, r, lane); continue; } r -= I_SQ;
        if (r < I_SQ) { p0_transpose_item(a.in[I_WQ], 1024, 1024, a.in[I_XAG], (bf16*)(ws + WS_WQ), 32, 0, scr, r, lane); continue; } r -= I_SQ;
        if (r < I_SQ) { p0_transpose_item(a.in[I_WK], 1024, 1024, a.in[I_MEMG], (bf16*)(ws + WS_WK), 32, 0, scr, r, lane); continue; } r -= I_SQ;
        if (r < I_SQ) { p0_transpose_item(a.in[I_WV], 1024, 1024, a.in[I_MEMG], (bf16*)(ws + WS_WV), 32, 0, scr, r, lane); continue; } r -= I_SQ;
        if (r < I_SQ) { p0_transpose_item(a.in[I_WO], 1024, 1024, nullptr, (bf16*)(ws + WS_WO), 32, 0, scr, r, lane); continue; } r -= I_SQ;
        if (r < I_1) { p0_transpose_item(a.in[I_W1], 1024, 4096, a.in[I_MLPG], (bf16*)(ws + WS_W1), 128, 0, scr, r, lane); continue; } r -= I_1;
        p0_transpose_item(a.in[I_W2], 4096, 1024, nullptr, (bf16*)(ws + WS_W2), 32, 0, scr, r, lane);
    }
    const float* x = a.in[I_X]; bf16* XB = (bf16*)(ws + WS_XB); float* rstd0 = (float*)(ws + WS_RSTD0);
    for (int m = gw; m < T; m += NGW) {
        const f32x4* xr = (const f32x4*)(x + (size_t)m * DM) + lane; f32x4 v[4]; float s = 0.f;
#pragma unroll
        for (int j = 0; j < 4; ++j) { v[j] = xr[64 * j]; s += (v[j].x * v[j].x + v[j].y * v[j].y) + (v[j].z * v[j].z + v[j].w * v[j].w); }
        s = wave_sum(s);
        if (lane == 0) rstd0[m] = 1.0f / sqrtf(s * (1.0f / DM) + EPS);
        v2u* o8 = (v2u*)(XB + (size_t)m * DM) + lane;
#pragma unroll
        for (int j = 0; j < 4; ++j) o8[64 * j] = (v2u){pk2(v[j].x, v[j].y), pk2(v[j].z, v[j].w)};
    }
    const float* mem = a.in[I_MEM]; bf16* MEMN = (bf16*)(ws + WS_MEMN);
    for (int m = gw; m < TMEM; m += NGW) {
        const f32x4* xr = (const f32x4*)(mem + (size_t)m * DM) + lane; f32x4 v[4]; float s = 0.f;
#pragma unroll
        for (int j = 0; j < 4; ++j) { v[j] = xr[64 * j]; s += (v[j].x * v[j].x + v[j].y * v[j].y) + (v[j].z * v[j].z + v[j].w * v[j].w); }
        s = wave_sum(s);
        const float rs = 1.0f / sqrtf(s * (1.0f / DM) + EPS);
        v2u* o8 = (v2u*)(MEMN + (size_t)m * DM) + lane;
#pragma unroll
        for (int j = 0; j < 4; ++j) o8[64 * j] = (v2u){pk2(v[j].x * rs, v[j].y * rs), pk2(v[j].z * rs, v[j].w * rs)};
    }
}


__device__ __forceinline__ float fast_logsig(float x) { return fminf(x, 0.f) - __logf(1.0f + __expf(-fabsf(x))); }
__device__ __forceinline__ void unpack8(const v4u r, float (&o)[8]) { o[0] = pg8::bf_lo(r.x); o[1] = pg8::bf_hi(r.x); o[2] = pg8::bf_lo(r.y); o[3] = pg8::bf_hi(r.y); o[4] = pg8::bf_lo(r.z); o[5] = pg8::bf_hi(r.z); o[6] = pg8::bf_lo(r.w); o[7] = pg8::bf_hi(r.w); }
__device__ __forceinline__ v4u pack8(const float (&y)[8]) { return (v4u){pg8::cvt_pk_bf16(y[0], y[1]), pg8::cvt_pk_bf16(y[2], y[3]), pg8::cvt_pk_bf16(y[4], y[5]), pg8::cvt_pk_bf16(y[6], y[7])}; }
__device__ __forceinline__ float scan_add(float v, int lane) {
#pragma unroll
    for (int o = 1; o < 64; o <<= 1) { const float u = __shfl_up(v, o); if (lane >= o) v += u; }
    return v;
}
__device__ __forceinline__ float scan_max(float v, int lane) {
#pragma unroll
    for (int o = 1; o < 64; o <<= 1) { const float u = __shfl_up(v, o); if (lane >= o) v = fmaxf(v, u); }
    return v;
}
__device__ __forceinline__ void phase_prep(const Args& a, LAS unsigned char* lds, int G) {
    const int tid = threadIdx.x, lane = tid & 63, w = __builtin_amdgcn_readfirstlane(tid >> 6);
    unsigned char* ws = a.ws;
    const bf16* U = (const bf16*)(ws + WS_U); const float* gates = (const float*)(ws + WS_GATES);
    bf16* QM = (bf16*)(ws + WS_QM); bf16* KM = (bf16*)(ws + WS_KM); bf16* QG = (bf16*)(ws + WS_QG); bf16* KG = (bf16*)(ws + WS_KG);
    float* LI = (float*)(ws + WS_LI); float* BF = (float*)(ws + WS_BF); float* MXP = (float*)(ws + WS_MXP); float* WG = (float*)(ws + WS_WG); float* EBL = (float*)(ws + WS_EBL);
    float* KS = (float*)(ws + WS_KS); float* BLM = (float*)(ws + WS_BLM); float* GMX = (float*)(ws + WS_GMX);
    LAS float* gl = (LAS float*)lds;
    LAS float* WGL = gl + 64 * 33;
    LAS float* WA = WGL + 256;
    LAS float* BL = WA + 16 * 256;
    LAS float* KSP = BL + 64 * 257;
    for (int i = tid; i < 16 * 256; i += 512) WA[i] = a.in[I_WA2][i];
    for (int ci = blockIdx.x; ci < T / 64; ci += G) {
        const size_t t0 = (size_t)ci * 64; const bool first = (ci & 63) == 0;
        { const f32x4 v = ((const f32x4*)(gates + t0 * 32))[tid]; const int t = tid >> 3, c4 = (tid & 7) * 4; gl[t * 33 + c4] = v.x; gl[t * 33 + c4 + 1] = v.y; gl[t * 33 + c4 + 2] = v.z; gl[t * 33 + c4 + 3] = v.w; }
        __syncthreads();
        if (w == 7) {
#pragma unroll
            for (int h = 0; h < 4; ++h) {
                const float li = gl[lane * 33 + h] + a.in[I_IB][h], lf = fast_logsig(gl[lane * 33 + 4 + h] + a.in[I_FB][h]);
                const float b = scan_add(lf, lane), bL = __shfl(b, 63), gg = bL - b + li, gmax = wave_max(gg), wg = __expf(gg - gmax), mx = scan_max(li - b, lane);
                LI[(t0 + lane) * 4 + h] = li; BF[(t0 + lane) * 4 + h] = b; MXP[(t0 + lane) * 4 + h] = mx; WG[(t0 + lane) * 4 + h] = wg; WGL[lane * 4 + h] = wg;
                if (lane == 0) { BLM[ci * 4 + h] = bL; GMX[ci * 4 + h] = gmax; }
            }
        }
        {
            float ga[16];
#pragma unroll
            for (int r = 0; r < 16; ++r) ga[r] = gl[lane * 33 + 8 + r];
            for (int cc = 0; cc < 32; ++cc) { const int c = 32 * w + cc; float xa = a.in[I_BA][c];
#pragma unroll
                for (int r = 0; r < 16; ++r) xa += ga[r] * WA[r * 256 + c];
                BL[lane * 257 + c] = scan_add(fast_logsig(xa) * (1.0f / 16.0f), lane); }
        }
        __syncthreads();
        {
            const int cg = tid & 127, tg = tid >> 7, c0 = cg * 8, tl0 = tg * 16;
            const float* cw = a.in[I_CONVW]; const float* cb = a.in[I_CONVB];
            float w0[8], w1[8], w2[8], w3[8], bb[8], xm3[8], xm2[8], xm1[8], ksum[8];
#pragma unroll
            for (int i = 0; i < 8; ++i) { w0[i] = cw[c0 + i]; w1[i] = cw[1024 + c0 + i]; w2[i] = cw[2048 + c0 + i]; w3[i] = cw[3072 + c0 + i]; bb[i] = cb[c0 + i]; ksum[i] = 0.f; }
            { v4u r3 = {0, 0, 0, 0}, r2 = {0, 0, 0, 0}, r1 = {0, 0, 0, 0};
              if (tl0 > 0 || !first) { r3 = *(const v4u*)(U + (t0 + tl0 - 3) * NU + c0); r2 = *(const v4u*)(U + (t0 + tl0 - 2) * NU + c0); r1 = *(const v4u*)(U + (t0 + tl0 - 1) * NU + c0); }
              unpack8(r3, xm3); unpack8(r2, xm2); unpack8(r1, xm1); }
            const bool isq = c0 < 512; const int hk = (c0 - 512) >> 7;
            bf16* dst = isq ? (QM + c0) : (KM + (c0 - 512));
            const float qsc = isq ? 0.08838834764831845f : 1.0f;
#pragma unroll
            for (int tb = 0; tb < 2; ++tb) {
                v4u rc[8];
#pragma unroll
                for (int i = 0; i < 8; ++i) rc[i] = *(const v4u*)(U + (t0 + tl0 + tb * 8 + i) * NU + c0);
#pragma unroll
                for (int tt = 0; tt < 8; ++tt) {
                    const size_t t = t0 + tl0 + tb * 8 + tt;
                    float xc[8], y[8]; unpack8(rc[tt], xc);
#pragma unroll
                    for (int i = 0; i < 8; ++i) { const float v = bb[i] + w0[i] * xm3[i] + w1[i] * xm2[i] + w2[i] * xm1[i] + w3[i] * xc[i]; y[i] = qsc * v / (1.0f + __expf(-v)); xm3[i] = xm2[i]; xm2[i] = xm1[i]; xm1[i] = xc[i]; }
                    *(v4u*)(dst + t * 512) = pack8(y);
                    if (!isq) { const float wg = WGL[(tl0 + tb * 8 + tt) * 4 + hk];
#pragma unroll
                        for (int i = 0; i < 8; ++i) ksum[i] += y[i] * wg; }
                }
            }
            if (!isq) {
#pragma unroll
                for (int i = 0; i < 8; ++i) KSP[tg * 512 + (c0 - 512) + i] = ksum[i]; }
        }
        {
            const int c8 = (tid & 31) * 8;
            v4u rq[4], rk[4];
#pragma unroll
            for (int i = 0; i < 4; ++i) { const int t = (tid >> 5) + 16 * i; rq[i] = *(const v4u*)(U + (t0 + t) * NU + 2048 + c8); rk[i] = *(const v4u*)(U + (t0 + t) * NU + 2304 + c8); }
#pragma unroll
            for (int i = 0; i < 4; ++i) { const int t = (tid >> 5) + 16 * i;
                float q[8], k[8], oq[8], ok[8]; unpack8(rq[i], q); unpack8(rk[i], k);
#pragma unroll
                for (int j = 0; j < 8; ++j) { const float b = BL[t * 257 + c8 + j]; oq[j] = q[j] * 0.125f * __expf(b); ok[j] = k[j] * __expf(-b); }
                *(v4u*)(QG + (t0 + t) * 256 + c8) = pack8(oq); *(v4u*)(KG + (t0 + t) * 256 + c8) = pack8(ok);
            }
            if (tid < 256) EBL[(size_t)ci * 256 + tid] = __expf(BL[63 * 257 + tid]);
        }
        __syncthreads();
        KS[(size_t)ci * 512 + tid] = (KSP[tid] + KSP[512 + tid]) + (KSP[1024 + tid] + KSP[1536 + tid]);
        __syncthreads();
    }
}

__device__ __forceinline__ void mlstm_scalar(LAS unsigned char* lds, int b, int h, const bf16* QM, const bf16* KM, const bf16* U, const float* LI, const float* BF, const float* gnorm, bf16* HM) {
    const int tid = threadIdx.x;
    LAS bf16* qs = (LAS bf16*)lds;
    LAS bf16* ks = qs + 64 * 136;
    LAS bf16* vs = ks + 64 * 136;
    LAS float* Ss = (LAS float*)(lds + 52224);
    LAS float* Cs = (LAS float*)(lds + 68864);
    LAS float* ns = (LAS float*)(lds + 134400);
    LAS float* bs = ns + 128; LAS float* lis = bs + 64; LAS float* wint = lis + 64; LAS float* dinv = wint + 64; LAS float* wgs = dinv + 64;
    LAS float* hs = (LAS float*)lds;
    for (int i = tid; i < 128 * 128; i += 512) Cs[i] = 0.f;
    if (tid < 128) ns[tid] = 0.f;
    float m = 0.f;
    __syncthreads();
    for (int c = 0; c < 64; ++c) {
        const size_t t0 = (size_t)b * SEQ + (size_t)c * 64;
        for (int i = tid; i < 1024; i += 512) { const int t = i >> 4, cc = i & 15;
            *(LAS v4u*)(qs + t * 136 + cc * 8) = *(const v4u*)(QM + (t0 + t) * 512 + h * 128 + cc * 8);
            *(LAS v4u*)(ks + t * 136 + cc * 8) = *(const v4u*)(KM + (t0 + t) * 512 + h * 128 + cc * 8);
            *(LAS v4u*)(vs + t * 136 + cc * 8) = *(const v4u*)(U + (t0 + t) * NU + 1024 + h * 128 + cc * 8); }
        if (tid < 64) { bs[tid] = BF[(t0 + tid) * 4 + h]; lis[tid] = LI[(t0 + tid) * 4 + h]; }
        __syncthreads();
        { const int t = tid >> 3, sg = tid & 7;
            for (int i = 0; i < 8; ++i) { const int s = sg + 8 * i; if (s <= t) { float acc = 0.f; _Pragma("unroll 1") for (int d = 0; d < 128; ++d) acc += bf2f(qs[t * 136 + d]) * bf2f(ks[s * 136 + d]); Ss[t * 65 + s] = acc; } } }
        __syncthreads();
        if (tid < 64) { const int t = tid; const float bt = bs[t]; float mloc = bt + m;
            _Pragma("unroll 1") for (int s = 0; s <= t; ++s) mloc = fmaxf(mloc, bt - bs[s] + lis[s]);
            float rowsum = 0.f;
            _Pragma("unroll 1") for (int s = 0; s <= t; ++s) { const float v = Ss[t * 65 + s] * expf(bt - bs[s] + lis[s] - mloc); Ss[t * 65 + s] = v; rowsum += v; }
            const float wi = expf(bt + m - mloc); float qn = 0.f;
            _Pragma("unroll 1") for (int d = 0; d < 128; ++d) qn += bf2f(qs[t * 136 + d]) * ns[d];
            const float den = rowsum + wi * qn;
            dinv[t] = 1.0f / fmaxf(fabsf(den), expf(-mloc)); wint[t] = wi; }
        __syncthreads();
        { const int t = tid >> 3, j = tid & 7; float vals[16], qc[16];
#pragma unroll
            for (int k = 0; k < 16; ++k) { vals[k] = 0.f; qc[k] = 0.f; }
            _Pragma("unroll 1") for (int s = 0; s <= t; ++s) { const float sv = Ss[t * 65 + s];
#pragma unroll
                for (int k = 0; k < 16; ++k) vals[k] += sv * bf2f(vs[s * 136 + j * 16 + k]); }
            _Pragma("unroll 1") for (int d = 0; d < 128; ++d) { const float qd = bf2f(qs[t * 136 + d]);
#pragma unroll
                for (int k = 0; k < 16; ++k) qc[k] += qd * Cs[d * 128 + j * 16 + k]; }
            const float wi = wint[t], di = dinv[t]; float ss = 0.f;
#pragma unroll
            for (int k = 0; k < 16; ++k) { vals[k] = (vals[k] + wi * qc[k]) * di; ss += vals[k] * vals[k]; }
            ss += __shfl_xor(ss, 1); ss += __shfl_xor(ss, 2); ss += __shfl_xor(ss, 4);
            const float rstd = 1.0f / sqrtf(ss * (1.0f / 128.0f) + EPS);
#pragma unroll
            for (int k = 0; k < 16; ++k) { const int col = h * 128 + j * 16 + k; const float mo = bf2f(U[(t0 + t) * NU + 1536 + col]);
                HM[(t0 + t) * 1024 + col] = (bf16)f2bf(vals[k] * rstd * gnorm[col] * (1.0f / (1.0f + expf(-mo)))); } }
        __syncthreads();
        const float bL = bs[63]; float m_new = bL + m;
        _Pragma("unroll 1") for (int s = 0; s < 64; ++s) m_new = fmaxf(m_new, bL - bs[s] + lis[s]);
        const float decay = expf(bL + m - m_new);
        if (tid < 64) wgs[tid] = expf(bL - bs[tid] + lis[tid] - m_new);
        __syncthreads();
        { const int e = tid & 127, dg = tid >> 7;
            _Pragma("unroll 1") for (int dd = 0; dd < 32; ++dd) { const int d = dg * 32 + dd; float acc = decay * Cs[d * 128 + e];
                _Pragma("unroll 1") for (int s = 0; s < 64; ++s) acc += wgs[s] * bf2f(ks[s * 136 + d]) * bf2f(vs[s * 136 + e]);
                Cs[d * 128 + e] = acc; } }
        if (tid < 128) { const int d = tid; float acc = decay * ns[d]; _Pragma("unroll 1") for (int s = 0; s < 64; ++s) acc += wgs[s] * bf2f(ks[s * 136 + d]); ns[d] = acc; }
        m = m_new;
        __syncthreads();
    }
}
__device__ __forceinline__ void gla_scalar(LAS unsigned char* lds, int b, int h, const bf16* QG, const bf16* KG, const bf16* KW, const bf16* U, const float* EBL, const float* gnorm, bf16* HM) {
    const int tid = threadIdx.x;
    LAS bf16* qg = (LAS bf16*)lds;
    LAS bf16* kg = qg + 64 * 72; LAS bf16* kw = kg + 64 * 72;
    LAS bf16* vs = kw + 64 * 72;
    LAS float* As = (LAS float*)(lds + 45056);
    LAS float* St = (LAS float*)(lds + 61696);
    LAS float* ebl = (LAS float*)(lds + 94464);
    LAS float* hs = (LAS float*)lds;
    for (int i = tid; i < 64 * 128; i += 512) St[i] = 0.f;
    __syncthreads();
    for (int c = 0; c < 64; ++c) {
        const size_t t0 = (size_t)b * SEQ + (size_t)c * 64;
        { const int t = tid >> 3, cc = tid & 7;
            *(LAS v4u*)(qg + t * 72 + cc * 8) = *(const v4u*)(QG + (t0 + t) * 256 + h * 64 + cc * 8);
            *(LAS v4u*)(kg + t * 72 + cc * 8) = *(const v4u*)(KG + (t0 + t) * 256 + h * 64 + cc * 8);
            *(LAS v4u*)(kw + t * 72 + cc * 8) = *(const v4u*)(KW + (t0 + t) * 256 + h * 64 + cc * 8); }
        for (int i = tid; i < 1024; i += 512) { const int t = i >> 4, cc = i & 15; *(LAS v4u*)(vs + t * 136 + cc * 8) = *(const v4u*)(U + (t0 + t) * NU + 2560 + h * 128 + cc * 8); }
        if (tid < 64) ebl[tid] = EBL[((size_t)b * 64 + c) * 256 + h * 64 + tid];
        __syncthreads();
        { const int t = tid >> 3, sg = tid & 7;
            for (int i = 0; i < 8; ++i) { const int s = sg + 8 * i; if (s <= t) { float acc = 0.f; _Pragma("unroll 1") for (int d = 0; d < 64; ++d) acc += bf2f(qg[t * 72 + d]) * bf2f(kg[s * 72 + d]); As[t * 65 + s] = acc; } } }
        __syncthreads();
        { const int t = tid >> 3, j = tid & 7; float vals[16];
#pragma unroll
            for (int k = 0; k < 16; ++k) vals[k] = 0.f;
            _Pragma("unroll 1") for (int s = 0; s <= t; ++s) { const float sv = As[t * 65 + s];
#pragma unroll
                for (int k = 0; k < 16; ++k) vals[k] += sv * bf2f(vs[s * 136 + j * 16 + k]); }
            _Pragma("unroll 1") for (int d = 0; d < 64; ++d) { const float qd = bf2f(qg[t * 72 + d]);
#pragma unroll
                for (int k = 0; k < 16; ++k) vals[k] += qd * St[d * 128 + j * 16 + k]; }
            float ss = 0.f;
#pragma unroll
            for (int k = 0; k < 16; ++k) ss += vals[k] * vals[k];
            ss += __shfl_xor(ss, 1); ss += __shfl_xor(ss, 2); ss += __shfl_xor(ss, 4);
            const float rstd = 1.0f / sqrtf(ss * (1.0f / 128.0f) + EPS);
#pragma unroll
            for (int k = 0; k < 16; ++k) { const int col = h * 128 + j * 16 + k; const float gr = bf2f(U[(t0 + t) * NU + 3072 + col]);
                HM[(t0 + t) * 1024 + 512 + col] = (bf16)f2bf(vals[k] * rstd * gnorm[col] * (gr / (1.0f + expf(-gr)))); } }
        __syncthreads();
        { const int e = tid & 127, dg = tid >> 7;
            _Pragma("unroll 1") for (int dd = 0; dd < 16; ++dd) { const int d = dg * 16 + dd; float acc = ebl[d] * St[d * 128 + e];
                _Pragma("unroll 1") for (int s = 0; s < 64; ++s) acc += bf2f(kw[s * 72 + d]) * bf2f(vs[s * 136 + e]);
                St[d * 128 + e] = acc; } }
        __syncthreads();
    }
}
__device__ __forceinline__ void phase_mixers_scalar(const Args& a, LAS unsigned char* lds, int G) {
    unsigned char* ws = a.ws;
    for (int w = blockIdx.x; w < 128; w += G) {
        if (w < 64) mlstm_scalar(lds, w >> 2, w & 3, (const bf16*)(ws + WS_QM), (const bf16*)(ws + WS_KM), (const bf16*)(ws + WS_U), (const float*)(ws + WS_LI), (const float*)(ws + WS_BF), a.in[I_MNG], (bf16*)(ws + WS_HM));
        else gla_scalar(lds, (w - 64) >> 2, (w - 64) & 3, (const bf16*)(ws + WS_QG), (const bf16*)(ws + WS_KG), (const bf16*)(ws + WS_KW), (const bf16*)(ws + WS_U), (const float*)(ws + WS_EBL), a.in[I_GNG], (bf16*)(ws + WS_HM));
        __syncthreads();
    }
}
__device__ __forceinline__ void phase_softmax(const float* SC, bf16* P, int G) {
    const int lane = threadIdx.x & 63, wave = threadIdx.x >> 6, gw = blockIdx.x * NWAVES + wave, NGW = G * NWAVES;
    for (int r = gw; r < T * 4; r += NGW) {
        const f32x4 v = *((const f32x4*)(SC + (size_t)r * 256) + lane);
        const float mx = wave_max(fmaxf(fmaxf(v.x, v.y), fmaxf(v.z, v.w)));
        const float e0 = expf(v.x - mx), e1 = expf(v.y - mx), e2 = expf(v.z - mx), e3 = expf(v.w - mx);
        const float inv = 1.0f / wave_sum((e0 + e1) + (e2 + e3));
        *((v2u*)(P + (size_t)r * 256) + lane) = (v2u){pk2(e0 * inv, e1 * inv), pk2(e2 * inv, e3 * inv)};
    }
}
__device__ __forceinline__ void phase_final(float* out, const float* ssp, const float* g, int G) {
    const int lane = threadIdx.x & 63, wave = threadIdx.x >> 6, gw = blockIdx.x * NWAVES + wave, NGW = G * NWAVES;
    f32x4 gv[4];
#pragma unroll
    for (int j = 0; j < 4; ++j) gv[j] = ((const f32x4*)g)[lane + 64 * j];
    for (int m = gw; m < T; m += NGW) {
        const float s = wave_sum(lane < 16 ? ssp[(size_t)m * 16 + lane] : 0.f);
        const float rs = 1.0f / sqrtf(s * (1.0f / DM) + EPS);
        f32x4* xr = (f32x4*)(out + (size_t)m * DM) + lane;
#pragma unroll
        for (int j = 0; j < 4; ++j) { f32x4 v = xr[64 * j]; xr[64 * j] = v * rs * gv[j]; }
    }
}

typedef short bf16x8 __attribute__((ext_vector_type(8)));
typedef short s16x4 __attribute__((ext_vector_type(4)));
#define MFMA16(x, y, acc) __builtin_amdgcn_mfma_f32_16x16x32_bf16((x), (y), (acc), 0, 0, 0)
__device__ __forceinline__ bf16x8 frag_n(const LAS bf16* base, int LD, int r0, int k0, int lane) { return *(const LAS bf16x8*)(base + (r0 + (lane & 15)) * LD + k0 + 8 * (lane >> 4)); }
__device__ __forceinline__ bf16x8 frag_t(const LAS bf16* base, int LD, int k0, int n0, int lane) {
    const int g = lane >> 4, q = (lane & 15) >> 2, p = lane & 3;
    const LAS bf16* a0 = base + (k0 + 8 * g + q) * LD + n0 + 4 * p;
    const s16x4 lo = __builtin_bit_cast(s16x4, __builtin_amdgcn_ds_read_tr16_b64_v4i16((LAS s16x4*)a0));
    const s16x4 hi = __builtin_bit_cast(s16x4, __builtin_amdgcn_ds_read_tr16_b64_v4i16((LAS s16x4*)(a0 + 4 * LD)));
    return __builtin_shufflevector(lo, hi, 0, 1, 2, 3, 4, 5, 6, 7);
}


__device__ __forceinline__ void phase_chain(const Args& a, LAS unsigned char* lds, int G) {
    const int tid = threadIdx.x, lane = tid & 63, w = __builtin_amdgcn_readfirstlane(tid >> 6), g = lane >> 4;
    unsigned char* ws = a.ws;
    const bf16* U = (const bf16*)(ws + WS_U); const bf16* KM = (const bf16*)(ws + WS_KM); const bf16* KG = (const bf16*)(ws + WS_KG);
    bf16* CT = (bf16*)(ws + WS_CT); bf16* ST = (bf16*)((unsigned char*)a.out + DO_ST);
    float* NST = (float*)(ws + WS_NST); float* MST = (float*)(ws + WS_MST);
    const float* KS = (const float*)(ws + WS_KS); const float* BLM = (const float*)(ws + WS_BLM); const float* GMX = (const float*)(ws + WS_GMX); const float* EBL = (const float*)(ws + WS_EBL); const float* WG = (const float*)(ws + WS_WG);
    const int bx = blockIdx.x, vcu = (G % 8 == 0) ? (bx % 8) * (G / 8) + bx / 8 : bx;
    constexpr int BUF = 36864, O_KM = 0, O_KG = 17408, O_VM = 26624, O_VG = 31744;
    for (int wk = vcu; wk < 256; wk += G) {
        const int bh = wk >> 2, q = wk & 3, b = bh >> 2, h = bh & 3;
        const bf16* km_g = KM + (size_t)b * SEQ * 512 + h * 128;
        const bf16* kg_g = KG + (size_t)b * SEQ * 256 + h * 64;
        const bool vm = tid < 256;
        const bf16* v_g = U + (size_t)b * SEQ * NU + (vm ? 1024 + h * 128 + 32 * q : 2560 + h * 128 + 32 * q);
        const float* wg_g = WG + (size_t)b * SEQ * 4 + h;
        const int r01 = tid >> 4, c01 = (tid & 15) * 8, r2 = tid >> 3, c2 = (tid & 7) * 8, r3 = (tid & 255) >> 2, c3 = (tid & 3) * 8;
        f32x4 cm[2] = {{0.f, 0.f, 0.f, 0.f}, {0.f, 0.f, 0.f, 0.f}}, cgs = {0.f, 0.f, 0.f, 0.f};
        float m = 0.f, nreg = 0.f;
        v4u pa0, pa1, pa2, pa3, pb0, pb1, pb2, pb3; float wa = 1.f, wb = 1.f;
#define CH_LOAD(P0, P1, P2, P3, WV, cc_) do { const size_t t1_ = (size_t)(cc_) * 64; \
            P0 = *(const v4u*)(km_g + (t1_ + r01) * 512 + c01); P1 = *(const v4u*)(km_g + (t1_ + r01 + 32) * 512 + c01); \
            P2 = *(const v4u*)(kg_g + (t1_ + r2) * 256 + c2); P3 = *(const v4u*)(v_g + (t1_ + r3) * NU + c3); WV = vm ? wg_g[(t1_ + r3) * 4] : 1.0f; } while (0)
#define CH_STAGE(P0, P1, P2, P3, WV, cc_) do { LAS unsigned char* Bn_ = lds + ((cc_) & 1) * BUF; \
            *(LAS v4u*)(Bn_ + O_KM + (r01 * 136 + c01) * 2) = P0; *(LAS v4u*)(Bn_ + O_KM + ((r01 + 32) * 136 + c01) * 2) = P1; \
            *(LAS v4u*)(Bn_ + O_KG + (r2 * 72 + c2) * 2) = P2; \
            { float v8_[8]; unpack8(P3, v8_); _Pragma("unroll") for (int i_ = 0; i_ < 8; ++i_) v8_[i_] *= WV; *(LAS v4u*)(Bn_ + (vm ? O_VM : O_VG) + (r3 * 40 + c3) * 2) = pack8(v8_); } } while (0)
#define CH_STEP(cc_) do { const int c_ = (cc_); const int it_ = (b * 64 + c_) * 4 + h; \
            const float bL = BLM[it_], gmx = GMX[it_]; \
            const f32x4 eb = *(const f32x4*)(EBL + (size_t)(b * 64 + c_) * 256 + h * 64 + 16 * (w & 3) + 4 * g); \
            const float ksv = (q == 0 && tid < 128) ? KS[(size_t)(b * 64 + c_) * 512 + h * 128 + tid] : 0.f; \
            const LAS unsigned char* Bf = lds + (c_ & 1) * BUF; \
            f32x4 pm0 = {0.f, 0.f, 0.f, 0.f}, pm1 = {0.f, 0.f, 0.f, 0.f}; \
            _Pragma("unroll") for (int ks = 0; ks < 2; ++ks) { \
                const bf16x8 xa = frag_t((const LAS bf16*)(Bf + O_KM), 136, 32 * ks, 16 * w, lane); \
                const bf16x8 y0 = frag_t((const LAS bf16*)(Bf + O_VM), 40, 32 * ks, 0, lane), y1 = frag_t((const LAS bf16*)(Bf + O_VM), 40, 32 * ks, 16, lane); \
                pm0 = MFMA16(xa, y0, pm0); pm1 = MFMA16(xa, y1, pm1); \
                const bf16x8 xg = frag_t((const LAS bf16*)(Bf + O_KG), 72, 32 * ks, 16 * (w & 3), lane); \
                const bf16x8 yg = frag_t((const LAS bf16*)(Bf + O_VG), 40, 32 * ks, 16 * (w >> 2), lane); \
                cgs = MFMA16(xg, yg, cgs); } \
            const float m_new = fmaxf(bL + m, gmx), decay = __expf(bL + m - m_new), scale2 = __expf(gmx - m_new); \
            cm[0] = cm[0] * decay + pm0 * scale2; cm[1] = cm[1] * decay + pm1 * scale2; cgs = cgs * eb; \
            nreg = nreg * decay + ksv * scale2; m = m_new; } while (0)
#define CH_STORE(cc_) do { const int it_ = (b * 64 + (cc_)) * 4 + h; \
            _Pragma("unroll") for (int j = 0; j < 2; ++j) *(v2u*)(CT + ((size_t)it_ * 128 + 32 * q + 16 * j + (lane & 15)) * 128 + 16 * w + 4 * g) = (v2u){pg8::cvt_pk_bf16(cm[j][0], cm[j][1]), pg8::cvt_pk_bf16(cm[j][2], cm[j][3])}; \
            *(v2u*)(ST + ((size_t)it_ * 128 + 32 * q + 16 * (w >> 2) + (lane & 15)) * 64 + 16 * (w & 3) + 4 * g) = (v2u){pg8::cvt_pk_bf16(cgs[0], cgs[1]), pg8::cvt_pk_bf16(cgs[2], cgs[3])}; \
            if (q == 0) { if (tid < 128) NST[(size_t)it_ * 128 + tid] = nreg; if (tid == 0) MST[it_] = m; } } while (0)
        CH_LOAD(pa0, pa1, pa2, pa3, wa, 0); CH_STAGE(pa0, pa1, pa2, pa3, wa, 0);
        CH_LOAD(pa0, pa1, pa2, pa3, wa, 1); CH_LOAD(pb0, pb1, pb2, pb3, wb, 2);
        for (int c = 0; c < 64; c += 2) {
            CH_STORE(c);
            __syncthreads();
            CH_STAGE(pa0, pa1, pa2, pa3, wa, c + 1);
            if (c + 3 < 63) CH_LOAD(pa0, pa1, pa2, pa3, wa, c + 3);
            CH_STEP(c);
            CH_STORE(c + 1);
            if (c + 1 == 63) break;
            __syncthreads();
            CH_STAGE(pb0, pb1, pb2, pb3, wb, c + 2);
            if (c + 4 < 63) CH_LOAD(pb0, pb1, pb2, pb3, wb, c + 4);
            CH_STEP(c + 1);
        }
#undef CH_LOAD
#undef CH_STAGE
#undef CH_STEP
#undef CH_STORE
        __syncthreads();
    }
}

__device__ __forceinline__ void mlstm_item(LAS unsigned char* lds, int b, int c, int h, const bf16* QM, const bf16* KM, const bf16* U, const float* LI, const float* BF,
                                           const bf16* CT, const float* NST, const float* MST, const float* gnorm, bf16* HM) {
    const int tid = threadIdx.x, lane = tid & 63, w = __builtin_amdgcn_readfirstlane(tid >> 6), g = lane >> 4;
    LAS bf16* Qs = (LAS bf16*)lds;
    LAS bf16* Ks = (LAS bf16*)(lds + 17408);
    LAS bf16* Vs = (LAS bf16*)(lds + 34816);
    LAS bf16* Cts = (LAS bf16*)(lds + 54272);
    LAS bf16* Sp = (LAS bf16*)(lds + 93440);
    LAS float* bs = (LAS float*)(lds + 102656); LAS float* lis = bs + 64; LAS float* mts = lis + 64; LAS float* wis = mts + 64;
    LAS float* H = (LAS float*)lds;
    const size_t t0 = (size_t)b * SEQ + (size_t)c * 64; const int it = (b * 64 + c) * 4 + h;
    for (int i = tid; i < 1024; i += 512) { const int t = i >> 4, cc = (i & 15) * 8;
        *(LAS v4u*)(Qs + t * 136 + cc) = *(const v4u*)(QM + (t0 + t) * 512 + h * 128 + cc);
        *(LAS v4u*)(Ks + t * 136 + cc) = *(const v4u*)(KM + (t0 + t) * 512 + h * 128 + cc);
        *(LAS v4u*)(Vs + t * 152 + cc) = *(const v4u*)(U + (t0 + t) * NU + 1024 + h * 128 + cc); }
    for (int i = tid; i < 2048; i += 512) { const int e = i >> 4, cc = (i & 15) * 8; *(LAS v4u*)(Cts + e * 136 + cc) = *(const v4u*)(CT + ((size_t)it * 128 + e) * 128 + cc); }
    if (tid < 64) { *(LAS v4u*)(Vs + tid * 152 + 128) = (v4u){0x00003F80u, 0u, 0u, 0u}; *(LAS v4u*)(Vs + tid * 152 + 136) = (v4u){0u, 0u, 0u, 0u};
        bs[tid] = BF[(t0 + tid) * 4 + h]; lis[tid] = LI[(t0 + tid) * 4 + h]; }
    if (tid < 128) Cts[128 * 136 + tid] = (bf16)f2bf(NST[(size_t)it * 128 + tid]);
    for (int i = tid; i < 15 * 16; i += 512) { const int e = 129 + (i >> 4), cc = (i & 15) * 8; *(LAS v4u*)(Cts + e * 136 + cc) = (v4u){0u, 0u, 0u, 0u}; }
    const float m_c = MST[it];
    __syncthreads();
    if (tid < 64) { const int t = tid; float mx = -3.0e38f;
        for (int s = 0; s <= t; ++s) mx = fmaxf(mx, lis[s] - bs[s]);
        const float bt = bs[t], mt = bt + fmaxf(mx, m_c); mts[t] = mt; wis[t] = __expf(bt + m_c - mt); }
    f32x4 sa[2] = {{0.f, 0.f, 0.f, 0.f}, {0.f, 0.f, 0.f, 0.f}};
    const int tt = w >> 1, si0 = 2 * (w & 1);
#pragma unroll
    for (int ks = 0; ks < 4; ++ks) { const bf16x8 y = frag_n(Qs, 136, 16 * tt, 32 * ks, lane);
#pragma unroll
        for (int j = 0; j < 2; ++j) sa[j] = MFMA16(frag_n(Ks, 136, 16 * (si0 + j), 32 * ks, lane), y, sa[j]); }
    __syncthreads();
    { const int t = 16 * tt + (lane & 15); const float bt = bs[t], mt = mts[t];
#pragma unroll
        for (int j = 0; j < 2; ++j) { const int s0 = 16 * (si0 + j) + 4 * g; float v[4];
#pragma unroll
            for (int r = 0; r < 4; ++r) { const int s = s0 + r; v[r] = (s <= t) ? sa[j][r] * __expf(bt - bs[s] + lis[s] - mt) : 0.f; }
            *(LAS v2u*)(Sp + t * 72 + s0) = (v2u){pg8::cvt_pk_bf16(v[0], v[1]), pg8::cvt_pk_bf16(v[2], v[3])}; } }
    __syncthreads();
    f32x4 a1[5], a2[5];
#pragma unroll
    for (int j = 0; j < 5; ++j) { a1[j] = (f32x4){0.f, 0.f, 0.f, 0.f}; a2[j] = (f32x4){0.f, 0.f, 0.f, 0.f}; }
    const int t2 = w & 3, e0 = (w >> 2) * 5, ne = (w >> 2) ? 4 : 5;
#pragma unroll
    for (int ks = 0; ks < 2; ++ks) { const bf16x8 y = frag_n(Sp, 72, 16 * t2, 32 * ks, lane);
#pragma unroll
        for (int j = 0; j < 5; ++j) if (j < ne) a1[j] = MFMA16(frag_t(Vs, 152, 32 * ks, 16 * (e0 + j), lane), y, a1[j]); }
#pragma unroll
    for (int ks = 0; ks < 4; ++ks) { const bf16x8 y = frag_n(Qs, 136, 16 * t2, 32 * ks, lane);
#pragma unroll
        for (int j = 0; j < 5; ++j) if (j < ne) a2[j] = MFMA16(frag_n(Cts, 136, 16 * (e0 + j), 32 * ks, lane), y, a2[j]); }
    __syncthreads();
    { const int t = 16 * t2 + (lane & 15); const float wi = wis[t];
#pragma unroll
        for (int j = 0; j < 5; ++j) if (j < ne) *(LAS f32x4*)(H + t * 148 + 16 * (e0 + j) + 4 * g) = a1[j] + a2[j] * wi; }
    __syncthreads();
    { const int t = tid >> 3, j = tid & 7; const float den = H[t * 148 + 128], dinv = 1.0f / fmaxf(fabsf(den), __expf(-mts[t]));
        float vals[16], mo[16]; float ss = 0.f;
#pragma unroll
        for (int k = 0; k < 4; ++k) { const f32x4 v = *(const LAS f32x4*)(H + t * 148 + 16 * j + 4 * k); vals[4 * k] = v[0] * dinv; vals[4 * k + 1] = v[1] * dinv; vals[4 * k + 2] = v[2] * dinv; vals[4 * k + 3] = v[3] * dinv; }
#pragma unroll
        for (int k = 0; k < 16; ++k) ss += vals[k] * vals[k];
        ss += __shfl_xor(ss, 1); ss += __shfl_xor(ss, 2); ss += __shfl_xor(ss, 4);
        const float rstd = 1.0f / sqrtf(ss * (1.0f / 128.0f) + EPS);
        const int col = h * 128 + 16 * j;
        { float t8[8]; unpack8(*(const v4u*)(U + (t0 + t) * NU + 1536 + col), t8);
#pragma unroll
          for (int k = 0; k < 8; ++k) mo[k] = t8[k];
          unpack8(*(const v4u*)(U + (t0 + t) * NU + 1536 + col + 8), t8);
#pragma unroll
          for (int k = 0; k < 8; ++k) mo[8 + k] = t8[k]; }
        float o[16];
#pragma unroll
        for (int k = 0; k < 16; ++k) o[k] = vals[k] * rstd * gnorm[col + k] / (1.0f + __expf(-mo[k]));
        float o0[8], o1[8];
#pragma unroll
        for (int k = 0; k < 8; ++k) { o0[k] = o[k]; o1[k] = o[8 + k]; }
        *(v4u*)(HM + (t0 + t) * 1024 + col) = pack8(o0); *(v4u*)(HM + (t0 + t) * 1024 + col + 8) = pack8(o1); }
    __syncthreads();
}
__device__ __forceinline__ void gla_item(LAS unsigned char* lds, int b, int c, int h, const bf16* QG, const bf16* KG, const bf16* U, const bf16* ST, const float* gnorm, bf16* HM) {
    const int tid = threadIdx.x, lane = tid & 63, w = __builtin_amdgcn_readfirstlane(tid >> 6), g = lane >> 4;
    LAS bf16* Qg = (LAS bf16*)lds;
    LAS bf16* Kg = (LAS bf16*)(lds + 9216);
    LAS bf16* Vs = (LAS bf16*)(lds + 18432);
    LAS bf16* Sts = (LAS bf16*)(lds + 35840);
    LAS bf16* Ap = (LAS bf16*)(lds + 54272);
    LAS float* H = (LAS float*)(lds + 64512);
    const size_t t0 = (size_t)b * SEQ + (size_t)c * 64; const int it = (b * 64 + c) * 4 + h;
    { const int t = tid >> 3, cc = (tid & 7) * 8;
        *(LAS v4u*)(Qg + t * 72 + cc) = *(const v4u*)(QG + (t0 + t) * 256 + h * 64 + cc);
        *(LAS v4u*)(Kg + t * 72 + cc) = *(const v4u*)(KG + (t0 + t) * 256 + h * 64 + cc); }
    for (int i = tid; i < 1024; i += 512) { const int t = i >> 4, cc = (i & 15) * 8; *(LAS v4u*)(Vs + t * 136 + cc) = *(const v4u*)(U + (t0 + t) * NU + 2560 + h * 128 + cc); }
    for (int i = tid; i < 1024; i += 512) { const int e = i >> 3, cc = (i & 7) * 8; *(LAS v4u*)(Sts + e * 72 + cc) = *(const v4u*)(ST + ((size_t)it * 128 + e) * 64 + cc); }
    __syncthreads();
    f32x4 sa[2] = {{0.f, 0.f, 0.f, 0.f}, {0.f, 0.f, 0.f, 0.f}};
    const int tt = w >> 1, si0 = 2 * (w & 1);
#pragma unroll
    for (int ks = 0; ks < 2; ++ks) { const bf16x8 y = frag_n(Qg, 72, 16 * tt, 32 * ks, lane);
#pragma unroll
        for (int j = 0; j < 2; ++j) sa[j] = MFMA16(frag_n(Kg, 72, 16 * (si0 + j), 32 * ks, lane), y, sa[j]); }
    { const int t = 16 * tt + (lane & 15);
#pragma unroll
        for (int j = 0; j < 2; ++j) { const int s0 = 16 * (si0 + j) + 4 * g; float v[4];
#pragma unroll
            for (int r = 0; r < 4; ++r) v[r] = (s0 + r <= t) ? sa[j][r] : 0.f;
            *(LAS v2u*)(Ap + t * 72 + s0) = (v2u){pg8::cvt_pk_bf16(v[0], v[1]), pg8::cvt_pk_bf16(v[2], v[3])}; } }
    __syncthreads();
    f32x4 ac[4];
#pragma unroll
    for (int j = 0; j < 4; ++j) ac[j] = (f32x4){0.f, 0.f, 0.f, 0.f};
    const int t2 = w & 3, e0 = (w >> 2) * 4;
#pragma unroll
    for (int ks = 0; ks < 2; ++ks) { const bf16x8 y = frag_n(Ap, 72, 16 * t2, 32 * ks, lane);
#pragma unroll
        for (int j = 0; j < 4; ++j) ac[j] = MFMA16(frag_t(Vs, 136, 32 * ks, 16 * (e0 + j), lane), y, ac[j]); }
#pragma unroll
    for (int ks = 0; ks < 2; ++ks) { const bf16x8 y = frag_n(Qg, 72, 16 * t2, 32 * ks, lane);
#pragma unroll
        for (int j = 0; j < 4; ++j) ac[j] = MFMA16(frag_n(Sts, 72, 16 * (e0 + j), 32 * ks, lane), y, ac[j]); }
    { const int t = 16 * t2 + (lane & 15);
#pragma unroll
        for (int j = 0; j < 4; ++j) *(LAS f32x4*)(H + t * 148 + 16 * (e0 + j) + 4 * g) = ac[j]; }
    __syncthreads();
    { const int t = tid >> 3, j = tid & 7; float vals[16], gr[16]; float ss = 0.f;
#pragma unroll
        for (int k = 0; k < 4; ++k) { const f32x4 v = *(const LAS f32x4*)(H + t * 148 + 16 * j + 4 * k); vals[4 * k] = v[0]; vals[4 * k + 1] = v[1]; vals[4 * k + 2] = v[2]; vals[4 * k + 3] = v[3]; }
#pragma unroll
        for (int k = 0; k < 16; ++k) ss += vals[k] * vals[k];
        ss += __shfl_xor(ss, 1); ss += __shfl_xor(ss, 2); ss += __shfl_xor(ss, 4);
        const float rstd = 1.0f / sqrtf(ss * (1.0f / 128.0f) + EPS);
        const int col = h * 128 + 16 * j;
        { float t8[8]; unpack8(*(const v4u*)(U + (t0 + t) * NU + 3072 + col), t8);
#pragma unroll
          for (int k = 0; k < 8; ++k) gr[k] = t8[k];
          unpack8(*(const v4u*)(U + (t0 + t) * NU + 3072 + col + 8), t8);
#pragma unroll
          for (int k = 0; k < 8; ++k) gr[8 + k] = t8[k]; }
        float o0[8], o1[8];
#pragma unroll
        for (int k = 0; k < 8; ++k) { o0[k] = vals[k] * rstd * gnorm[col + k] * gr[k] / (1.0f + __expf(-gr[k])); o1[k] = vals[8 + k] * rstd * gnorm[col + 8 + k] * gr[8 + k] / (1.0f + __expf(-gr[8 + k])); }
        *(v4u*)(HM + (t0 + t) * 1024 + 512 + col) = pack8(o0); *(v4u*)(HM + (t0 + t) * 1024 + 512 + col + 8) = pack8(o1); }
    __syncthreads();
}
__device__ __forceinline__ void phase_mixout(const Args& a, LAS unsigned char* lds, int G) {
    unsigned char* ws = a.ws;
    for (int i = blockIdx.x; i < 8192; i += G) {
        const int mode = i >> 12, r = i & 4095, h = r & 3, bc = r >> 2, b = bc >> 6, c = bc & 63;
        if (mode == 0) mlstm_item(lds, b, c, h, (const bf16*)(ws + WS_QM), (const bf16*)(ws + WS_KM), (const bf16*)(ws + WS_U), (const float*)(ws + WS_LI), (const float*)(ws + WS_BF),
                                  (const bf16*)(ws + WS_CT), (const float*)(ws + WS_NST), (const float*)(ws + WS_MST), a.in[I_MNG], (bf16*)(ws + WS_HM));
        else gla_item(lds, b, c, h, (const bf16*)(ws + WS_QG), (const bf16*)(ws + WS_KG), (const bf16*)(ws + WS_U), (const bf16*)((const unsigned char*)a.out + DO_ST), a.in[I_GNG], (bf16*)(ws + WS_HM));
    }
}

#ifndef MK_N_LAUNCHES
#define MK_N_LAUNCHES 1
#endif
constexpr int NPHASES = 14;
__global__ void __launch_bounds__(NWAVES * 64, 2) fwd_kernel(Args args) {
    extern __shared__ __attribute__((aligned(16))) unsigned char lds_raw[];
    LAS unsigned char* lds = (LAS unsigned char*)lds_raw;
    const int tid = threadIdx.x, G = gridDim.x, bid = blockIdx.x;
    unsigned char* ws = args.ws;
    volatile LAS unsigned* MISC = (volatile LAS unsigned*)(lds + MISC_OFF);
    for (int u = tid; u < (LDS_BYTES - MISC_OFF) / 4; u += NWAVES * 64) ((LAS unsigned*)(lds + MISC_OFF))[u] = 0u;
    __syncthreads();
    XcdBarrier bar; bar.bar = (unsigned*)(ws + WS_CTL) + CW_BAR; bar.x = 0; bar.st = nullptr;
    if (MK_N_LAUNCHES == 1) bar = xcd_barrier_post((unsigned*)(ws + WS_CTL) + CW_BAR, MISC + 8);
    const int lo = args.ph_lo, hi = args.ph_hi;
#ifndef PH_MASK
#define PH_MASK 0x3fff
#endif
#define IN(k) (((PH_MASK >> (k)) & 1) && lo <= (k) && (k) < hi)
#ifndef PH_REP
#define PH_REP 0
#endif
#define PHASE(k) if (IN(k)) for (int rp_ = 0; rp_ <= ((PH_REP >> (k)) & 1); ++rp_)
#define SEAM(k) do { if (IN(k) && IN((k) + 1)) xcd_barrier(bar); } while (0)
    using namespace pg8;
    const bf16_t* XB = (const bf16_t*)(ws + WS_XB);
    PHASE(0) { phase_prologue(args, lds, G); SEAM(0); }
    PHASE(1) {
        { Gemm g{XB, (const bf16_t*)(ws + WS_WIN), 1024, 1024, 1024}; StaticOrder S; S.init(T, NINP, G, bid);
          typedef Epi<1, 0, 0, 0, 0, 1> E_t; E_t E{(void*)(ws + WS_U), NU, (const float*)(ws + WS_RSTD0), 1.f, nullptr, nullptr, (float*)(ws + WS_GATES)};
          gemm_phase<E_t, StaticOrder, true, true>(lds, g, S, E); }
        { Gemm g{(const bf16_t*)(ws + WS_MEMN), (const bf16_t*)(ws + WS_WK), 1024, 1024, 1024}; StaticOrder S; S.init(TMEM, 1024, G, bid);
          typedef Epi<0, 0, 0, 0, 0, 0> E_t; E_t E{(void*)(ws + WS_KB), 1024, nullptr, 1.f, nullptr, nullptr, nullptr};
          gemm_phase<E_t, StaticOrder, true, true>(lds, g, S, E); }
        { Gemm g{(const bf16_t*)(ws + WS_WV), (const bf16_t*)(ws + WS_MEMN), 1024, 1024, 1024}; StaticOrder S; S.init(1024, TMEM, G, bid);
          typedef Epi<0, 0, 0, 0, 0, 0> E_t; E_t E{(void*)(ws + WS_VT), 4096, nullptr, 1.f, nullptr, nullptr, nullptr};
          gemm_phase<E_t, StaticOrder, true, true>(lds, g, S, E); }
        SEAM(1);
    }
    PHASE(2) { phase_prep(args, lds, G); SEAM(2); }
    PHASE(3) { phase_chain(args, lds, G); SEAM(3); }
    PHASE(4) { phase_mixout(args, lds, G); SEAM(4); }
    PHASE(5) {
        Gemm g{(const bf16_t*)(ws + WS_HM), (const bf16_t*)(ws + WS_WOUT), 1024, 1024, 1024}; StaticOrder S; S.init(T, 1024, G, bid);
        typedef Epi<0, 0, 1, 0, 1, 0> E_t; E_t E{(void*)(ws + WS_X1), 1024, nullptr, 1.f, (const void*)args.in[I_X], (float*)(ws + WS_SSP1), nullptr};
        gemm_phase<E_t, StaticOrder, true, true>(lds, g, S, E); SEAM(5);
    }
    PHASE(6) {
        Gemm g{(const bf16_t*)(ws + WS_X1), (const bf16_t*)(ws + WS_WQ), 1024, 1024, 1024}; StaticOrder S; S.init(T, 1024, G, bid);
        typedef Epi<2, 0, 0, 0, 0, 0> E_t; E_t E{(void*)(ws + WS_HQ), 1024, (const float*)(ws + WS_SSP1), 0.0625f, nullptr, nullptr, nullptr};
        gemm_phase<E_t, StaticOrder, true, true>(lds, g, S, E); SEAM(6);
    }
    PHASE(7) {
        Gemm g{(const bf16_t*)(ws + WS_HQ), (const bf16_t*)(ws + WS_KB), 1024, 1024, 256}; AttnOrder<0> S{G, bid};
        typedef Epi<0, 0, 0, 1, 0, 0> E_t; E_t E{(void*)args.out, 1024, nullptr, 1.f, nullptr, nullptr, nullptr};
        gemm_phase<E_t, AttnOrder<0>, true, true>(lds, g, S, E); SEAM(7);
    }
    PHASE(8) { phase_softmax(args.out, (bf16*)(ws + WS_P), G); SEAM(8); }
    PHASE(9) {
        Gemm g{(const bf16_t*)(ws + WS_P), (const bf16_t*)(ws + WS_VT), 1024, 4096, 256}; AttnOrder<1> S{G, bid};
        typedef Epi<0, 0, 0, 0, 0, 0> E_t; E_t E{(void*)(ws + WS_ATT), 1024, nullptr, 1.f, nullptr, nullptr, nullptr};
        gemm_phase<E_t, AttnOrder<1>, true, true>(lds, g, S, E); SEAM(9);
    }
    PHASE(10) {
        Gemm g{(const bf16_t*)(ws + WS_ATT), (const bf16_t*)(ws + WS_WO), 1024, 1024, 1024}; StaticOrder S; S.init(T, 1024, G, bid);
        typedef Epi<0, 0, 2, 0, 1, 0> E_t; E_t E{(void*)(ws + WS_X2), 1024, nullptr, 1.f, (const void*)(ws + WS_X1), (float*)(ws + WS_SSP2), nullptr};
        gemm_phase<E_t, StaticOrder, true, true>(lds, g, S, E); SEAM(10);
    }
    PHASE(11) {
        Gemm g{(const bf16_t*)(ws + WS_X2), (const bf16_t*)(ws + WS_W1), 1024, 1024, 1024}; StaticOrder S; S.init(T, DFF, G, bid);
        typedef Epi<2, 1, 0, 0, 0, 0> E_t; E_t E{(void*)(ws + WS_HID), DFF, (const float*)(ws + WS_SSP2), 1.f, nullptr, nullptr, nullptr};
        gemm_phase<E_t, StaticOrder, true, true>(lds, g, S, E); SEAM(11);
    }
    PHASE(12) {
        Gemm g{(const bf16_t*)(ws + WS_HID), (const bf16_t*)(ws + WS_W2), DFF, DFF, DFF}; StaticOrder S; S.init(T, 1024, G, bid);
        typedef Epi<0, 0, 2, 1, 1, 0> E_t; E_t E{(void*)args.out, 1024, nullptr, 1.f, (const void*)(ws + WS_X2), (float*)(ws + WS_SSP3), nullptr};
        gemm_phase<E_t, StaticOrder, true, true>(lds, g, S, E); SEAM(12);
    }
    if (IN(13)) phase_final(args.out, (const float*)(ws + WS_SSP3), args.in[I_FING], G);
#undef IN
#undef SEAM
}

extern "C" void kernel_launch(void* const* d_in, const int* in_sizes, int n_in, void* d_out, int out_size, void* d_ws, size_t ws_size, hipStream_t stream) {
    static int grid = 0;
    if (grid == 0) {
        if (n_in != 23 || in_sizes[0] != T * DM || out_size != T * DM || ws_size < WS_END) { fprintf(stderr, "kernel_launch: unexpected shapes (n_in %d, in0 %d, out %d, ws %zu); nothing launched\n", n_in, n_in > 0 ? in_sizes[0] : -1, out_size, ws_size); grid = -1; return; }
        int dev = 0, cus = 0;
        if (hipGetDevice(&dev) != hipSuccess || hipDeviceGetAttribute(&cus, hipDeviceAttributeMultiprocessorCount, dev) != hipSuccess) { grid = -1; return; }
        if (hipFuncSetAttribute((const void*)fwd_kernel, hipFuncAttributeMaxDynamicSharedMemorySize, LDS_BYTES) != hipSuccess) { fprintf(stderr, "kernel_launch: hipFuncSetAttribute failed\n"); grid = -1; return; }
        int per_cu = 0;
        if (hipOccupancyMaxActiveBlocksPerMultiprocessor(&per_cu, (const void*)fwd_kernel, NWAVES * 64, LDS_BYTES) != hipSuccess || per_cu < 1) fprintf(stderr, "kernel_launch: occupancy query reports %d\n", per_cu);
        (void)hipGetLastError();
        grid = cus;
    }
    if (grid < 0) return;
    (void)hipMemsetAsync((char*)d_ws + WS_CTL, 0, CTL_ZERO_BYTES, stream);
    Args a{};
    for (int i = 0; i < 23; ++i) a.in[i] = (const float*)d_in[i];
    a.out = (float*)d_out; a.ws = (unsigned char*)d_ws;
    if (MK_N_LAUNCHES == 1) { a.ph_lo = 0; a.ph_hi = NPHASES; hipLaunchKernelGGL(fwd_kernel, dim3(grid), dim3(NWAVES * 64), LDS_BYTES, stream, a); }
    else for (int p = 0; p < NPHASES; ++p) { a.ph_lo = p; a.ph_hi = p + 1; hipLaunchKernelGGL(fwd_kernel, dim3(grid), dim3(NWAVES * 64), LDS_BYTES, stream, a); }
}
```

```cpp
#include <hip/hip_runtime.h>
#include <cstdio>
#include <cstdint>
namespace pg8 {
#define PG8_LAS __attribute__((address_space(3)))
typedef unsigned short bf16_t;
typedef short bf16x8 __attribute__((ext_vector_type(8)));
typedef float f32x4 __attribute__((ext_vector_type(4)));
typedef unsigned u32x4 __attribute__((ext_vector_type(4)));
constexpr int BM = 256, BK = 64, HALF = 128, HTB = HALF * BK * 2  , STAGE_BYTES = 8 * HTB, NXCD = 8, WGM = 8;

__host__ __device__ __forceinline__ int lds_byte(int r, int c) { const int st = (r >> 4) * 2 + (c >> 5), rr = r & 15, cc = c & 31, ob = rr * 64 + cc * 2; return st * 1024 + (ob ^ (((ob >> 9) & 1) << 5)); }
__host__ __device__ __forceinline__ void stage_rc(int b, int& R, int& C) { const int st = b / 1024, sb = b % 1024, swz = sb ^ (((sb >> 9) & 1) << 5); R = (st >> 1) * 16 + swz / 64; C = (st & 1) * 32 + (swz % 64) / 2; }
__host__ __device__ __forceinline__ int perm32(int rho) { const int n = rho >> 4, i = rho & 15; return 8 * (i >> 2) + 4 * n + (i & 3); }


struct Unit { int pm, pn; };
struct Gemm { const bf16_t* A; const bf16_t* Bt; int lda, ldb, K; };

struct StaticOrder {
    int nM, nN, nwg, G, c;
    __host__ __device__ void init(int M, int N, int G_, int c_) { nM = M / BM; nN = N / BM; nwg = nM * nN; G = G_; c = c_; }
    __host__ __device__ bool next(int i, Unit& u) const {
        const long L = (long)i * G + c; if (L >= nwg) return false;
        int wgid = (int)L; { const int q = nwg / NXCD, r = nwg % NXCD, xcd = wgid % NXCD, off = wgid / NXCD; wgid = (xcd < r ? xcd * (q + 1) : r * (q + 1) + (xcd - r) * q) + off; }
        const int nig = WGM * nN, gid = wgid / nig, fm = gid * WGM, gsz = (nM - fm) < WGM ? (nM - fm) : WGM;
        u.pm = fm + ((wgid % nig) % gsz); u.pn = (wgid % nig) / gsz; return true;
    }
    __device__ __forceinline__ const char* aptr(const Gemm& g, const Unit& u) const { return (const char*)g.A + (size_t)u.pm * BM * g.lda * 2; }
    __device__ __forceinline__ const char* bptr(const Gemm& g, const Unit& u) const { return (const char*)g.Bt + (size_t)u.pn * BM * g.ldb * 2; }
    __device__ __forceinline__ void a_ready(const Unit&) const {}
    __device__ __forceinline__ void done(const Unit&) const {}
};
template <int MODE> struct AttnOrder {
    int G, c;
    __device__ bool next(int i, Unit& u) const { const long L = (long)i * G + c; if (L >= 1024) return false; u.pm = (int)(L >> 2); u.pn = (int)(L & 3); return true; }
    __device__ __forceinline__ const char* aptr(const Gemm& g, const Unit& u) const { return (const char*)g.A + ((size_t)u.pm * 256 * 1024 + (size_t)u.pn * 256) * 2; }
    __device__ __forceinline__ const char* bptr(const Gemm& g, const Unit& u) const {
        return MODE == 0 ? (const char*)g.Bt + ((size_t)(u.pm >> 4) * 256 * 1024 + (size_t)u.pn * 256) * 2
                         : (const char*)g.Bt + ((size_t)u.pn * 256 * 4096 + (size_t)(u.pm >> 4) * 256) * 2; }
    __device__ __forceinline__ void a_ready(const Unit&) const {}
    __device__ __forceinline__ void done(const Unit&) const {}
};

__device__ __forceinline__ unsigned cvt_pk_bf16(float lo, float hi) { unsigned r; asm volatile("v_cvt_pk_bf16_f32 %0, %1, %2" : "=v"(r) : "v"(lo), "v"(hi)); return r; }
__device__ __forceinline__ float bf_lo(unsigned w) { return __uint_as_float(w << 16); }
__device__ __forceinline__ float bf_hi(unsigned w) { return __uint_as_float(w & 0xffff0000u); }

template <int RS  , int ACT, int RES, int OUTF32, int SSQ, int GATE>
struct Epi {
    static constexpr bool PERM = true, AFTER_DRAIN = false;
    void* out; int ldc; const float* rs; float scale; const void* base; float* ssp; float* gates;
    __device__ __forceinline__ void operator()(const f32x4 (&acc)[2][2][4][2], const Unit& u, int wr, int wc, int fr, int fq) const {
        const int row0 = u.pm * BM + wr * 64 + fr, col0 = u.pn * BM + wc * 32 + 8 * fq;
        const bool gate_tile = GATE && (u.pn == 14);
        float rsv[2][4];
#pragma unroll
        for (int ai = 0; ai < 2; ++ai)
#pragma unroll
            for (int m = 0; m < 4; ++m) { const int r = row0 + ai * HALF + m * 16;
                if (RS == 1) rsv[ai][m] = rs[r];
                else if (RS == 2) { const f32x4 q = *(const f32x4*)(rs + (size_t)r * 16 + 4 * fq); rsv[ai][m] = (q[0] + q[1]) + (q[2] + q[3]); }
                else rsv[ai][m] = 1.f; }
        if (RS == 2) {
#pragma unroll
            for (int ai = 0; ai < 2; ++ai)
#pragma unroll
                for (int m = 0; m < 4; ++m) { float s = rsv[ai][m]; s += __shfl_xor(s, 16); s += __shfl_xor(s, 32); rsv[ai][m] = 1.0f / sqrtf(s * (1.0f / 1024.0f) + 1e-6f); }
        }
#pragma unroll
        for (int ai = 0; ai < 2; ++ai) {
            u32x4 bw[4][2]; f32x4 bf[4][2][2];
            if (RES == 2) {
#pragma unroll
                for (int m = 0; m < 4; ++m)
#pragma unroll
                    for (int bj = 0; bj < 2; ++bj) bw[m][bj] = *(const u32x4*)((const bf16_t*)base + (size_t)(row0 + ai * HALF + m * 16) * ldc + col0 + bj * HALF);
            }
            if (RES == 1) {
#pragma unroll
                for (int m = 0; m < 4; ++m)
#pragma unroll
                    for (int bj = 0; bj < 2; ++bj) { const f32x4* bp = (const f32x4*)((const float*)base + (size_t)(row0 + ai * HALF + m * 16) * ldc + col0 + bj * HALF); bf[m][bj][0] = bp[0]; bf[m][bj][1] = bp[1]; }
            }
#pragma unroll
            for (int m = 0; m < 4; ++m) {
                const int r = row0 + ai * HALF + m * 16;
                const float rv = rsv[ai][m] * scale;
                float ss = 0.f;
#pragma unroll
                for (int bj = 0; bj < 2; ++bj) {
                    f32x4 v0 = acc[ai][bj][m][0] * rv, v1 = acc[ai][bj][m][1] * rv;
                    if (ACT == 1) { v0 = __builtin_elementwise_max(v0, (f32x4){0.f, 0.f, 0.f, 0.f}); v1 = __builtin_elementwise_max(v1, (f32x4){0.f, 0.f, 0.f, 0.f}); v0 = v0 * v0; v1 = v1 * v1; }
                    const size_t off = (size_t)r * ldc + col0 + bj * HALF;
                    if (RES == 1) { v0 = v0 + bf[m][bj][0]; v1 = v1 + bf[m][bj][1]; }
                    if (RES == 2) { const u32x4 w = bw[m][bj];
                        v0 = v0 + (f32x4){bf_lo(w.x), bf_hi(w.x), bf_lo(w.y), bf_hi(w.y)}; v1 = v1 + (f32x4){bf_lo(w.z), bf_hi(w.z), bf_lo(w.w), bf_hi(w.w)}; }
                    if (SSQ) ss += ((v0[0] * v0[0] + v0[1] * v0[1]) + (v0[2] * v0[2] + v0[3] * v0[3])) + ((v1[0] * v1[0] + v1[1] * v1[1]) + (v1[2] * v1[2] + v1[3] * v1[3]));
                    if (gate_tile) { if (bj == 0 && wc == 0 && fq < 3) { f32x4* gp = (f32x4*)(gates + (size_t)r * 32 + 8 * fq); gp[0] = v0; gp[1] = v1; } }
                    else if (OUTF32) { f32x4* op = (f32x4*)((float*)out + off); op[0] = v0; op[1] = v1; }
                    else { u32x4 w; w.x = cvt_pk_bf16(v0[0], v0[1]); w.y = cvt_pk_bf16(v0[2], v0[3]); w.z = cvt_pk_bf16(v1[0], v1[1]); w.w = cvt_pk_bf16(v1[2], v1[3]);
                        *(u32x4*)((bf16_t*)out + off) = w; }
                }
                if (SSQ) { ss += __shfl_xor(ss, 16); ss += __shfl_xor(ss, 32); if (fq == 0) ssp[(size_t)r * 16 + u.pn * 4 + wc] = ss; }
            }
            if (RES != 0) asm volatile("" ::: "memory");
        }
    }
};

template <class Epi, class Sched, bool ALIGN_EPI = false, bool SP2 = false>
__device__ __forceinline__ void gemm_phase(PG8_LAS unsigned char* lds, const Gemm g, const Sched& S, const Epi& E) {
    const int tid = threadIdx.x, wid = __builtin_amdgcn_readfirstlane(tid >> 6), lane = tid & 63, wr = wid >> 2, wc = wid & 3, fr = lane & 15, fq = lane >> 4;
    const int K = g.K, nt = K / BK;
    unsigned voffA[2], voffB[2];
#pragma unroll
    for (int i = 0; i < 2; ++i) { int R, C; stage_rc(tid * 16 + i * 8192, R, C); const int Rb = Epi::PERM ? ((R & ~31) + perm32(R & 31)) : R;
        voffA[i] = (unsigned)(R * g.lda + C) * 2u; voffB[i] = (unsigned)(Rb * g.ldb + C) * 2u; }
    const size_t kstep = (size_t)(BK * 2);
    const size_t hstepA = (size_t)HALF * g.lda * 2, hstepB = (size_t)HALF * g.ldb * 2;
    const unsigned ldsw = (unsigned)wid * 1024u;
    const int aoff = lds_byte(wr * 64 + fr, fq * 8), boff = lds_byte(wc * 32 + fr, fq * 8);
#define PG8_SA(b, h) (((b) * 2 + (h)) * HTB)
#define PG8_SB(b, h) ((4 + (b) * 2 + (h)) * HTB)
#define PG8_STAGE(bufoff, gbase, voff) do { _Pragma("unroll") for (int _i = 0; _i < 2; ++_i) \
        __builtin_amdgcn_global_load_lds((const unsigned*)((const char*)(gbase) + (voff)[_i]), (PG8_LAS unsigned*)(lds + (bufoff) + ldsw + _i * 8192), 16, 0, 0); } while (0)
#define PG8_LDA(dst, b, h) do { _Pragma("unroll") for (int m = 0; m < 4; ++m) _Pragma("unroll") for (int k = 0; k < 2; ++k) dst[m][k] = *(const PG8_LAS bf16x8*)(lds + PG8_SA(b, h) + aoff + m * 2048 + k * 1024); } while (0)
#define PG8_LDB(dst, b, h) do { _Pragma("unroll") for (int n = 0; n < 2; ++n) _Pragma("unroll") for (int k = 0; k < 2; ++k) dst[n][k] = *(const PG8_LAS bf16x8*)(lds + PG8_SB(b, h) + boff + n * 2048 + k * 1024); } while (0)
#define PG8_MMA(ai, bj, At, Bt) do { __builtin_amdgcn_s_setprio(1); _Pragma("unroll") for (int m = 0; m < 4; ++m) _Pragma("unroll") for (int n = 0; n < 2; ++n) _Pragma("unroll") for (int k = 0; k < 2; ++k) \
        acc[ai][bj][m][n] = __builtin_amdgcn_mfma_f32_16x16x32_bf16(Bt[n][k], At[m][k], acc[ai][bj][m][n], 0, 0, 0); __builtin_amdgcn_s_setprio(0); } while (0)
#define PG8_WAIT_V(n) asm volatile("s_waitcnt vmcnt(" #n ")" ::: "memory")
#define PG8_WAIT_L(n) asm volatile("s_waitcnt lgkmcnt(" #n ")" ::: "memory")
#define PG8_BAR __builtin_amdgcn_s_barrier()
#define PG8_SCHED __builtin_amdgcn_sched_barrier(0)
    Unit cur, nxt; int ui = 0;
    if (!S.next(0, cur)) return;
    f32x4 acc[2][2][4][2];
#pragma unroll
    for (int a = 0; a < 2; ++a)
#pragma unroll
        for (int b = 0; b < 2; ++b)
#pragma unroll
            for (int m = 0; m < 4; ++m)
#pragma unroll
                for (int n = 0; n < 2; ++n) acc[a][b][m][n] = (f32x4){0.f, 0.f, 0.f, 0.f};
    bf16x8 At[4][2], B0[2][2], B1[2][2];
    const char* cA = S.aptr(g, cur); const char* cB = S.bptr(g, cur);
    S.a_ready(cur);
    if constexpr (SP2) {
        PG8_STAGE(PG8_SB(0, 0), cB, voffB); PG8_STAGE(PG8_SB(0, 1), cB + hstepB, voffB); PG8_STAGE(PG8_SA(0, 0), cA, voffA); PG8_STAGE(PG8_SA(0, 1), cA + hstepA, voffA);
        if (wr == 1) PG8_BAR;
        PG8_WAIT_V(2); PG8_BAR;
        PG8_STAGE(PG8_SB(1, 0), cB + kstep, voffB); PG8_STAGE(PG8_SA(1, 0), cA + kstep, voffA); PG8_STAGE(PG8_SB(1, 1), cB + hstepB + kstep, voffB);
        PG8_WAIT_V(6); PG8_BAR;
    } else {
        PG8_STAGE(PG8_SB(0, 0), cB, voffB); PG8_STAGE(PG8_SA(0, 0), cA, voffA); PG8_STAGE(PG8_SB(0, 1), cB + hstepB, voffB); PG8_STAGE(PG8_SA(0, 1), cA + hstepA, voffA);
        if (wr == 1) PG8_BAR;
        PG8_WAIT_V(4); PG8_BAR;
        PG8_STAGE(PG8_SB(1, 0), cB + kstep, voffB); PG8_STAGE(PG8_SA(1, 0), cA + kstep, voffA); PG8_STAGE(PG8_SB(1, 1), cB + hstepB + kstep, voffB);
        PG8_WAIT_V(6); PG8_BAR;
    }
    for (;;) {
        const bool has_next = S.next(ui + 1, nxt);
        const char* nA = has_next ? S.aptr(g, nxt) : cA; const char* nB = has_next ? S.bptr(g, nxt) : cB;
        _Pragma("unroll 1") for (int t = 0; t < nt; t += 2) {
            const bool last = (t == nt - 2);
            const char* a1 = cA + (size_t)(t + 1) * kstep;
            const char* a2 = last ? nA : cA + (size_t)(t + 2) * kstep; const char* b2 = last ? nB : cB + (size_t)(t + 2) * kstep;
            const char* a3 = a2 + kstep; const char* b3 = b2 + kstep;
            if (last && has_next) S.a_ready(nxt);
            if constexpr (SP2) {
            PG8_LDB(B0, 0, 0); PG8_LDB(B1, 0, 1); PG8_SCHED; PG8_LDA(At, 0, 0); PG8_STAGE(PG8_SA(1, 1), a1 + hstepA, voffA);
            PG8_WAIT_V(8); PG8_WAIT_L(0); PG8_BAR; PG8_MMA(0, 0, At, B0); PG8_MMA(0, 1, At, B1); PG8_BAR; PG8_SCHED;
            PG8_LDA(At, 0, 1); PG8_STAGE(PG8_SB(0, 0), b2, voffB); PG8_STAGE(PG8_SB(0, 1), b2 + hstepB, voffB); PG8_STAGE(PG8_SA(0, 0), a2, voffA);
            PG8_WAIT_V(8); PG8_WAIT_L(0); PG8_BAR; PG8_MMA(1, 0, At, B0); PG8_MMA(1, 1, At, B1); PG8_BAR; PG8_SCHED;
            PG8_LDB(B0, 1, 0); PG8_LDB(B1, 1, 1); PG8_SCHED; PG8_LDA(At, 1, 0); PG8_STAGE(PG8_SA(0, 1), a2 + hstepA, voffA);
            PG8_WAIT_V(8); PG8_WAIT_L(0); PG8_BAR; PG8_MMA(0, 0, At, B0); PG8_MMA(0, 1, At, B1); PG8_BAR; PG8_SCHED;
            PG8_LDA(At, 1, 1); PG8_STAGE(PG8_SB(1, 0), b3, voffB); PG8_STAGE(PG8_SB(1, 1), b3 + hstepB, voffB); PG8_STAGE(PG8_SA(1, 0), a3, voffA);
            PG8_WAIT_V(8); PG8_WAIT_L(0); PG8_BAR; PG8_MMA(1, 0, At, B0); PG8_MMA(1, 1, At, B1); PG8_BAR; PG8_SCHED;
            } else {
            PG8_LDB(B0, 0, 0); PG8_SCHED; PG8_LDA(At, 0, 0); PG8_STAGE(PG8_SA(1, 1), a1 + hstepA, voffA);
            PG8_WAIT_L(8); PG8_BAR; PG8_WAIT_L(0); PG8_MMA(0, 0, At, B0); PG8_BAR; PG8_SCHED;
            PG8_LDB(B1, 0, 1); PG8_STAGE(PG8_SB(0, 0), b2, voffB);
            PG8_BAR; PG8_WAIT_L(0); PG8_MMA(0, 1, At, B1); PG8_BAR;
            PG8_LDA(At, 0, 1); PG8_STAGE(PG8_SA(0, 0), a2, voffA);
            PG8_BAR; PG8_WAIT_L(0); PG8_MMA(1, 0, At, B0); PG8_BAR; PG8_SCHED;
            PG8_STAGE(PG8_SB(0, 1), b2 + hstepB, voffB);
            PG8_WAIT_V(6); PG8_BAR; PG8_MMA(1, 1, At, B1); PG8_BAR;
            PG8_LDB(B0, 1, 0); PG8_SCHED; PG8_LDA(At, 1, 0); PG8_STAGE(PG8_SA(0, 1), a2 + hstepA, voffA);
            PG8_WAIT_L(8); PG8_BAR; PG8_WAIT_L(0); PG8_MMA(0, 0, At, B0); PG8_BAR; PG8_SCHED;
            PG8_LDB(B1, 1, 1); PG8_STAGE(PG8_SB(1, 0), b3, voffB);
            PG8_BAR; PG8_WAIT_L(0); PG8_MMA(0, 1, At, B1); PG8_BAR;
            PG8_LDA(At, 1, 1); PG8_STAGE(PG8_SA(1, 0), a3, voffA);
            PG8_BAR; PG8_WAIT_L(0); PG8_MMA(1, 0, At, B0); PG8_BAR; PG8_SCHED;
            PG8_STAGE(PG8_SB(1, 1), b3 + hstepB, voffB);
            PG8_WAIT_V(6); PG8_BAR; PG8_MMA(1, 1, At, B1); PG8_BAR;
            }
        }
        if constexpr (ALIGN_EPI) { if (wr == 0) PG8_BAR; }
        if constexpr (!Epi::AFTER_DRAIN) { E(acc, cur, wr, wc, fr, fq); S.done(cur); }
        if (!has_next) break;
#pragma unroll
        for (int a = 0; a < 2; ++a)
#pragma unroll
            for (int b = 0; b < 2; ++b)
#pragma unroll
                for (int m = 0; m < 4; ++m)
#pragma unroll
                    for (int n = 0; n < 2; ++n) acc[a][b][m][n] = (f32x4){0.f, 0.f, 0.f, 0.f};
        cur = nxt; cA = nA; cB = nB; ++ui;
        if constexpr (ALIGN_EPI) { if (wr == 1) PG8_BAR; }
    }
    PG8_WAIT_V(0);
    if constexpr (!ALIGN_EPI) { if (wr == 0) PG8_BAR; }
    PG8_BAR;
    if constexpr (Epi::AFTER_DRAIN) { E.fused(acc, cur, wr, wc, fr, fq, lds, wid, lane); S.done(cur); }
#undef PG8_SA
#undef PG8_SB
#undef PG8_STAGE
#undef PG8_LDA
#undef PG8_LDB
#undef PG8_MMA
#undef PG8_WAIT_V
#undef PG8_WAIT_L
#undef PG8_BAR
#undef PG8_SCHED
}
}

constexpr int NWAVES = 8;
constexpr int BATCH = 16, SEQ = 4096, DM = 1024, T = BATCH * SEQ, MEML = 256, TMEM = BATCH * MEML, DFF = 4096, NU = 3584, NINP = 3840;
constexpr float EPS = 1e-6f;
constexpr size_t MiB = 1u << 20;
constexpr size_t WS_CTL = 0, CTL_ZERO_BYTES = 1 * MiB;
constexpr size_t WS_WIN = 2 * MiB, WS_WOUT = 10 * MiB, WS_WQ = 12 * MiB, WS_WK = 14 * MiB, WS_WV = 16 * MiB, WS_WO = 18 * MiB, WS_W1 = 20 * MiB, WS_W2 = 28 * MiB;
constexpr size_t WS_MEMN = 36 * MiB, WS_KB = 44 * MiB, WS_VT = 52 * MiB, WS_RSTD0 = 60 * MiB, WS_SSP1 = 61 * MiB, WS_SSP2 = 65 * MiB, WS_SSP3 = 69 * MiB;
constexpr size_t WS_GATES = 73 * MiB, WS_LI = 81 * MiB, WS_BF = 82 * MiB, WS_EBL = 83 * MiB;
constexpr size_t WS_XB = 96 * MiB, WS_X1 = 96 * MiB, WS_U = 224 * MiB, WS_QM = 672 * MiB, WS_KM = 736 * MiB, WS_QG = 800 * MiB, WS_KG = 832 * MiB, WS_KW = 864 * MiB;
constexpr size_t WS_HM = 896 * MiB, WS_X2 = 896 * MiB, WS_HQ = 224 * MiB, WS_P = 352 * MiB, WS_ATT = 480 * MiB, WS_HID = 224 * MiB, WS_END = 1024 * MiB;
constexpr size_t WS_NST = 84 * MiB, WS_KS = 86 * MiB, WS_MST = 88 * MiB, WS_BLM = 88 * MiB + 65536, WS_GMX = 88 * MiB + 131072, WS_CT = 96 * MiB;
constexpr size_t WS_MXP = 89 * MiB, WS_WG = 90 * MiB;
constexpr size_t DO_KWM = 0, DO_ST = 64 * MiB;
constexpr int CW_BAR = 4096;
constexpr int LDS_BYTES = 163840, MISC_OFF = LDS_BYTES - 512;

#define LAS __attribute__((address_space(3)))
typedef unsigned short bf16;
typedef unsigned v4u __attribute__((ext_vector_type(4)));
typedef unsigned v2u __attribute__((ext_vector_type(2)));
typedef float f32x4 __attribute__((ext_vector_type(4)));
#ifndef PROBE_K
#define PROBE_K -1
#endif
#define RT() __builtin_amdgcn_s_memrealtime()
#define PROBE_ADD(id, a, b) do { if (PROBE_K == (id) && threadIdx.x == 0 && blockIdx.x == 0) { volatile LAS unsigned long long* acc_ = (volatile LAS unsigned long long*)(lds + MISC_OFF + 128); *acc_ = *acc_ + ((b) - (a)); } } while (0)
#define LDS_WAIT() asm volatile("s_waitcnt lgkmcnt(0)" ::: "memory")
__device__ __forceinline__ unsigned f2bf(float f) { unsigned u = __builtin_bit_cast(unsigned, f); return (u + 0x7fffu + ((u >> 16) & 1u)) >> 16; }
__device__ __forceinline__ unsigned pk2(float lo, float hi) { return f2bf(lo) | (f2bf(hi) << 16); }
__device__ __forceinline__ float bf2f(bf16 v) { return __uint_as_float((unsigned)v << 16); }
__device__ __forceinline__ float wave_sum(float v) {
#pragma unroll
    for (int o = 1; o < 64; o <<= 1) v += __shfl_xor(v, o);
    return v;
}
__device__ __forceinline__ float wave_max(float v) {
#pragma unroll
    for (int o = 1; o < 64; o <<= 1) v = fmaxf(v, __shfl_xor(v, o));
    return v;
}
__device__ __forceinline__ float logsig(float x) { return fminf(x, 0.f) - log1pf(expf(-fabsf(x))); }

#define XB_TMO      128
#define XB_XCNT(j)  (256  + 64 * (j))
#define XB_XSUB(j)  (1280 + 64 * (j))
#define XB_XGEN(j)  (2304 + 64 * (j))
#define XB_TOP      3328
#define XB_TOPGEN   3392
#define XCD_BAR_WORDS 3456
#define XB_SPIN_CAP (1u << 18)

__device__ __forceinline__ unsigned xb_ld(unsigned* p)              { return __hip_atomic_load(p, __ATOMIC_RELAXED, __HIP_MEMORY_SCOPE_AGENT); }
__device__ __forceinline__ unsigned xb_add(unsigned* p, unsigned v) { return __hip_atomic_fetch_add(p, v, __ATOMIC_RELAXED, __HIP_MEMORY_SCOPE_AGENT); }
__device__ __forceinline__ unsigned xb_xcc_id() { return (unsigned)__builtin_amdgcn_s_getreg((3 << 11) | 20) & 0xFu; }
#define XB_SPIN(cond, bar) do { unsigned _sp = 0; while (cond) { __builtin_amdgcn_s_sleep(1); \
    if ((++_sp & 255u) == 0u) { if (xb_ld(&(bar)[XB_TMO])) break; if (_sp > XB_SPIN_CAP) { atomicAdd(&(bar)[XB_TMO], 1u); break; } } } } while (0)

struct XcdBarrier {
    unsigned* bar; unsigned x;
    volatile LAS unsigned* st;
};

__device__ __forceinline__ XcdBarrier xcd_barrier_post(unsigned* bar, volatile LAS unsigned* st) {
    XcdBarrier b; b.bar = bar; b.x = xb_xcc_id(); b.st = st;
    if (threadIdx.x == 0) (void)xb_add(&bar[XB_XCNT(b.x)], 1u);
    return b;
}
__device__ __forceinline__ void xcd_barrier_complete(unsigned* bar, unsigned x, unsigned& nloc, unsigned& nx) {
    const unsigned G = gridDim.x * gridDim.y * gridDim.z;
    unsigned sum, cnt, mine, sp = 0u;
    for (;;) {
        sum = 0u; cnt = 0u; mine = 0u;
#pragma unroll
        for (unsigned j = 0; j < 16; ++j) { const unsigned c = xb_ld(&bar[XB_XCNT(j)]); sum += c; cnt += (c > 0u) ? 1u : 0u; mine = (j == x) ? c : mine; }
        if (sum == G) break;
        __builtin_amdgcn_s_sleep(1);
        if ((++sp & 255u) == 0u) { if (xb_ld(&bar[XB_TMO])) break; if (sp > XB_SPIN_CAP) { atomicAdd(&bar[XB_TMO], 1u); break; } }
    }
    nloc = mine > 0u ? mine : 1u; nx = cnt > 0u ? cnt : 1u;
}

__device__ __forceinline__ void xcd_barrier(const XcdBarrier& b) {
    asm volatile("s_waitcnt vmcnt(0)" ::: "memory");
    __syncthreads();
    if (threadIdx.x == 0) {
        unsigned* bar = b.bar;
        __builtin_amdgcn_s_waitcnt(0);
        unsigned nloc = b.st[0], nx = b.st[1];
        if (nloc == 0u) { xcd_barrier_complete(bar, b.x, nloc, nx); b.st[0] = nloc; b.st[1] = nx; }
        const unsigned old = xb_add(&bar[XB_XSUB(b.x)], 1u);
        const unsigned gen = old / nloc;
        if (old + 1u == (gen + 1u) * nloc) {
            __builtin_amdgcn_fence(__ATOMIC_RELEASE, "agent");
            asm volatile("s_waitcnt vmcnt(0)" ::: "memory");
            const unsigned og = xb_add(&bar[XB_TOP], 1u);
            const unsigned tg = og / nx;
            if (og + 1u == (tg + 1u) * nx) xb_add(&bar[XB_TOPGEN], 1u);
            else XB_SPIN(xb_ld(&bar[XB_TOPGEN]) == tg, bar);
            __builtin_amdgcn_fence(__ATOMIC_ACQUIRE, "agent");
            xb_add(&bar[XB_XGEN(b.x)], 1u);
            asm volatile("s_waitcnt vmcnt(0)" ::: "memory");
        } else {
            XB_SPIN(xb_ld(&bar[XB_XGEN(b.x)]) == gen, bar);
            __builtin_amdgcn_fence(__ATOMIC_ACQUIRE, "agent");
            asm volatile("s_waitcnt vmcnt(0)" ::: "memory");
        }
    }
    __syncthreads();
}

struct Args { const float* in[23]; float* out; unsigned char* ws; int ph_lo, ph_hi; };
enum { I_X = 0, I_MEM, I_MIXG, I_WIN, I_CONVW, I_CONVB, I_IB, I_FB, I_MNG, I_WA2, I_BA, I_GNG, I_WOUT, I_XAG, I_MEMG, I_WQ, I_WK, I_WV, I_WO, I_MLPG, I_W1, I_W2, I_FING };

__device__ __forceinline__ int map_col(int mode, int nd) {
    if (mode == 0) return nd;
    if (nd < 2048) return nd; if (nd < 3584) return nd + 8; if (nd < 3592) return nd - 3584 + 2048; if (nd < 3608) return nd; return -1;
}
template <bool HASG, int MODE>
__device__ __forceinline__ void p0_transpose_item(const float* W, int K, int N, const float* gain, bf16* WT, int ndst_blk, LAS float* scr, int item, int lane) {
    const int kb = item / ndst_blk, nb = item % ndst_blk, k0 = 64 * kb, n0 = 32 * nb;
    const int ns = map_col(MODE, n0 + (lane & 31)), nsc = ns < 0 ? 0 : ns;
    const float gsel = ns < 0 ? 0.f : 1.f;
    float vv[32];
#pragma unroll
    for (int i = 0; i < 32; ++i) vv[i] = W[(size_t)(k0 + 2 * i + (lane >> 5)) * N + nsc];
    if (HASG) {
#pragma unroll
        for (int i = 0; i < 32; ++i) vv[i] *= gain[k0 + 2 * i + (lane >> 5)];
    }
#pragma unroll
    for (int i = 0; i < 32; ++i) scr[(2 * i + (lane >> 5)) * 33 + (lane & 31)] = vv[i] * gsel;
    LDS_WAIT(); asm volatile("" ::: "memory");
    const int c = lane & 7;
#pragma unroll
    for (int j = 0; j < 4; ++j) { const int n = (lane >> 3) + 8 * j; const LAS float* s = scr + (8 * c) * 33 + n;
        v4u o; o.x = pk2(s[0 * 33], s[1 * 33]); o.y = pk2(s[2 * 33], s[3 * 33]); o.z = pk2(s[4 * 33], s[5 * 33]); o.w = pk2(s[6 * 33], s[7 * 33]);
        *(v4u*)(WT + (size_t)(n0 + n) * K + k0 + 8 * c) = o; }
    LDS_WAIT(); asm volatile("" ::: "memory");
}

__device__ __forceinline__ void phase_prologue(const Args& a, LAS unsigned char* lds, int G) {
    const int tid = threadIdx.x, lane = tid & 63, wave = tid >> 6;
    unsigned char* ws = a.ws;
    LAS float* scr = (LAS float*)(lds + wave * 16384);
    const int gw = blockIdx.x * NWAVES + wave, NGW = G * NWAVES;
    constexpr int I_IN = 16 * 120, I_SQ = 16 * 32, I_1 = 16 * 128, I_2 = 64 * 32;
    constexpr int NITEMS = I_IN + 5 * I_SQ + I_1 + I_2;
    for (int it = gw; it < NITEMS; it += NGW) {
        int r = it;
        if (r < I_IN) { p0_transpose_item<true, 1>(a.in[I_WIN], 1024, 3608, a.in[I_MIXG], (bf16*)(ws + WS_WIN), 120, scr, r, lane); continue; } r -= I_IN;
        if (r < I_SQ) { p0_transpose_item<false, 0>(a.in[I_WOUT], 1024, 1024, nullptr, (bf16*)(ws + WS_WOUT), 32, scr, r, lane); continue; } r -= I_SQ;
        if (r < I_SQ) { p0_transpose_item<true, 0>(a.in[I_WQ], 1024, 1024, a.in[I_XAG], (bf16*)(ws + WS_WQ), 32, scr, r, lane); continue; } r -= I_SQ;
        if (r < I_SQ) { p0_transpose_item<true, 0>(a.in[I_WK], 1024, 1024, a.in[I_MEMG], (bf16*)(ws + WS_WK), 32, scr, r, lane); continue; } r -= I_SQ;
        if (r < I_SQ) { p0_transpose_item<true, 0>(a.in[I_WV], 1024, 1024, a.in[I_MEMG], (bf16*)(ws + WS_WV), 32, scr, r, lane); continue; } r -= I_SQ;
        if (r < I_SQ) { p0_transpose_item<false, 0>(a.in[I_WO], 1024, 1024, nullptr, (bf16*)(ws + WS_WO), 32, scr, r, lane); continue; } r -= I_SQ;
        if (r < I_1) { p0_transpose_item<true, 0>(a.in[I_W1], 1024, 4096, a.in[I_MLPG], (bf16*)(ws + WS_W1), 128, scr, r, lane); continue; } r -= I_1;
        p0_transpose_item<false, 0>(a.in[I_W2], 4096, 1024, nullptr, (bf16*)(ws + WS_W2), 32, scr, r, lane);
    }
    const float* x = a.in[I_X]; bf16* XB = (bf16*)(ws + WS_XB); float* rstd0 = (float*)(ws + WS_RSTD0);
    for (int m0 = gw * 4; m0 < T; m0 += NGW * 4) {
        f32x4 v[4][4];
#pragma unroll
        for (int r = 0; r < 4; ++r) { const f32x4* xr = (const f32x4*)(x + (size_t)(m0 + r) * DM) + lane;
#pragma unroll
            for (int j = 0; j < 4; ++j) v[r][j] = __builtin_nontemporal_load(xr + 64 * j); }
#pragma unroll
        for (int r = 0; r < 4; ++r) { float s = 0.f;
#pragma unroll
            for (int j = 0; j < 4; ++j) s += (v[r][j].x * v[r][j].x + v[r][j].y * v[r][j].y) + (v[r][j].z * v[r][j].z + v[r][j].w * v[r][j].w);
            s = wave_sum(s);
            if (lane == 0) rstd0[m0 + r] = 1.0f / sqrtf(s * (1.0f / DM) + EPS);
            v2u* o8 = (v2u*)(XB + (size_t)(m0 + r) * DM) + lane;
#pragma unroll
            for (int j = 0; j < 4; ++j) o8[64 * j] = (v2u){pg8::cvt_pk_bf16(v[r][j].x, v[r][j].y), pg8::cvt_pk_bf16(v[r][j].z, v[r][j].w)}; }
    }
    const float* mem = a.in[I_MEM]; bf16* MEMN = (bf16*)(ws + WS_MEMN);
    for (int m = gw; m < TMEM; m += NGW) {
        const f32x4* xr = (const f32x4*)(mem + (size_t)m * DM) + lane; f32x4 v[4]; float s = 0.f;
#pragma unroll
        for (int j = 0; j < 4; ++j) { v[j] = xr[64 * j]; s += (v[j].x * v[j].x + v[j].y * v[j].y) + (v[j].z * v[j].z + v[j].w * v[j].w); }
        s = wave_sum(s);
        const float rs = 1.0f / sqrtf(s * (1.0f / DM) + EPS);
        v2u* o8 = (v2u*)(MEMN + (size_t)m * DM) + lane;
#pragma unroll
        for (int j = 0; j < 4; ++j) o8[64 * j] = (v2u){pk2(v[j].x * rs, v[j].y * rs), pk2(v[j].z * rs, v[j].w * rs)};
    }
}

__device__ __forceinline__ float fast_logsig(float x) { return fminf(x, 0.f) - __logf(1.0f + __expf(-fabsf(x))); }
__device__ __forceinline__ void unpack8(const v4u r, float (&o)[8]) { o[0] = pg8::bf_lo(r.x); o[1] = pg8::bf_hi(r.x); o[2] = pg8::bf_lo(r.y); o[3] = pg8::bf_hi(r.y); o[4] = pg8::bf_lo(r.z); o[5] = pg8::bf_hi(r.z); o[6] = pg8::bf_lo(r.w); o[7] = pg8::bf_hi(r.w); }
__device__ __forceinline__ v4u pack8(const float (&y)[8]) { return (v4u){pg8::cvt_pk_bf16(y[0], y[1]), pg8::cvt_pk_bf16(y[2], y[3]), pg8::cvt_pk_bf16(y[4], y[5]), pg8::cvt_pk_bf16(y[6], y[7])}; }
__device__ __forceinline__ float scan_add(float v, int lane) {
#pragma unroll
    for (int o = 1; o < 64; o <<= 1) { const float u = __shfl_up(v, o); if (lane >= o) v += u; }
    return v;
}
__device__ __forceinline__ float scan_max(float v, int lane) {
#pragma unroll
    for (int o = 1; o < 64; o <<= 1) { const float u = __shfl_up(v, o); if (lane >= o) v = fmaxf(v, u); }
    return v;
}
__device__ __forceinline__ void phase_prep(const Args& a, LAS unsigned char* lds, int G) {
    const int tid = threadIdx.x, lane = tid & 63, w = __builtin_amdgcn_readfirstlane(tid >> 6);
    unsigned char* ws = a.ws;
    const bf16* U = (const bf16*)(ws + WS_U); const float* gates = (const float*)(ws + WS_GATES);
    bf16* QM = (bf16*)(ws + WS_QM); bf16* KM = (bf16*)(ws + WS_KM); bf16* QG = (bf16*)(ws + WS_QG); bf16* KG = (bf16*)(ws + WS_KG);
    float* LI = (float*)(ws + WS_LI); float* BF = (float*)(ws + WS_BF); float* MXP = (float*)(ws + WS_MXP); float* WG = (float*)(ws + WS_WG); float* EBL = (float*)(ws + WS_EBL);
    float* KS = (float*)(ws + WS_KS); float* BLM = (float*)(ws + WS_BLM); float* GMX = (float*)(ws + WS_GMX);
    LAS float* gl = (LAS float*)lds;
    LAS float* WGL = gl + 64 * 33;
    LAS float* WA = WGL + 256;
    LAS float* BL = WA + 16 * 256;
    LAS float* KSP = BL + 64 * 257;
    for (int i = tid; i < 16 * 256; i += 512) WA[i] = a.in[I_WA2][i];
    for (int ci = blockIdx.x; ci < T / 64; ci += G) {
        const size_t t0 = (size_t)ci * 64; const bool first = (ci & 63) == 0;
        { const f32x4 v = ((const f32x4*)(gates + t0 * 32))[tid]; const int t = tid >> 3, c4 = (tid & 7) * 4; gl[t * 33 + c4] = v.x; gl[t * 33 + c4 + 1] = v.y; gl[t * 33 + c4 + 2] = v.z; gl[t * 33 + c4 + 3] = v.w; }
        __syncthreads();
        if (w == 7) {
#pragma unroll
            for (int h = 0; h < 4; ++h) {
                const float li = gl[lane * 33 + h] + a.in[I_IB][h], lf = fast_logsig(gl[lane * 33 + 4 + h] + a.in[I_FB][h]);
                const float b = scan_add(lf, lane), bL = __shfl(b, 63), gg = bL - b + li, gmax = wave_max(gg), wg = __expf(gg - gmax), mx = scan_max(li - b, lane);
                LI[(t0 + lane) * 4 + h] = li; BF[(t0 + lane) * 4 + h] = b; MXP[(t0 + lane) * 4 + h] = mx; WG[(t0 + lane) * 4 + h] = wg; WGL[lane * 4 + h] = wg;
                if (lane == 0) { BLM[ci * 4 + h] = bL; GMX[ci * 4 + h] = gmax; }
            }
        }
        {
            float ga[16];
#pragma unroll
            for (int r = 0; r < 16; ++r) ga[r] = gl[lane * 33 + 8 + r];
            for (int cc = 0; cc < 32; ++cc) { const int c = 32 * w + cc; float xa = a.in[I_BA][c];
#pragma unroll
                for (int r = 0; r < 16; ++r) xa += ga[r] * WA[r * 256 + c];
                BL[lane * 257 + c] = scan_add(fast_logsig(xa) * (1.0f / 16.0f), lane); }
        }
        __syncthreads();
        {
            const int cg = tid & 127, tg = tid >> 7, c0 = cg * 8, tl0 = tg * 16;
            const float* cw = a.in[I_CONVW]; const float* cb = a.in[I_CONVB];
            float w0[8], w1[8], w2[8], w3[8], bb[8], xm3[8], xm2[8], xm1[8], ksum[8];
#pragma unroll
            for (int i = 0; i < 8; ++i) { w0[i] = cw[c0 + i]; w1[i] = cw[1024 + c0 + i]; w2[i] = cw[2048 + c0 + i]; w3[i] = cw[3072 + c0 + i]; bb[i] = cb[c0 + i]; ksum[i] = 0.f; }
            { v4u r3 = {0, 0, 0, 0}, r2 = {0, 0, 0, 0}, r1 = {0, 0, 0, 0};
              if (tl0 > 0 || !first) { r3 = *(const v4u*)(U + (t0 + tl0 - 3) * NU + c0); r2 = *(const v4u*)(U + (t0 + tl0 - 2) * NU + c0); r1 = *(const v4u*)(U + (t0 + tl0 - 1) * NU + c0); }
              unpack8(r3, xm3); unpack8(r2, xm2); unpack8(r1, xm1); }
            const bool isq = c0 < 512; const int hk = (c0 - 512) >> 7;
            bf16* dst = isq ? (QM + c0) : (KM + (c0 - 512));
            const float qsc = isq ? 0.08838834764831845f : 1.0f;
#pragma unroll
            for (int tb = 0; tb < 2; ++tb) {
                v4u rc[8];
#pragma unroll
                for (int i = 0; i < 8; ++i) rc[i] = *(const v4u*)(U + (t0 + tl0 + tb * 8 + i) * NU + c0);
#pragma unroll
                for (int tt = 0; tt < 8; ++tt) {
                    const size_t t = t0 + tl0 + tb * 8 + tt;
                    float xc[8], y[8]; unpack8(rc[tt], xc);
#pragma unroll
                    for (int i = 0; i < 8; ++i) { const float v = bb[i] + w0[i] * xm3[i] + w1[i] * xm2[i] + w2[i] * xm1[i] + w3[i] * xc[i]; y[i] = qsc * v / (1.0f + __expf(-v)); xm3[i] = xm2[i]; xm2[i] = xm1[i]; xm1[i] = xc[i]; }
                    *(v4u*)(dst + t * 512) = pack8(y);
                    if (!isq) { const float wg = WGL[(tl0 + tb * 8 + tt) * 4 + hk];
#pragma unroll
                        for (int i = 0; i < 8; ++i) ksum[i] += y[i] * wg; }
                }
            }
            if (!isq) {
#pragma unroll
                for (int i = 0; i < 8; ++i) KSP[tg * 512 + (c0 - 512) + i] = ksum[i]; }
        }
        {
            const int c8 = (tid & 31) * 8;
            v4u rq[4], rk[4];
#pragma unroll
            for (int i = 0; i < 4; ++i) { const int t = (tid >> 5) + 16 * i; rq[i] = *(const v4u*)(U + (t0 + t) * NU + 2048 + c8); rk[i] = *(const v4u*)(U + (t0 + t) * NU + 2304 + c8); }
#pragma unroll
            for (int i = 0; i < 4; ++i) { const int t = (tid >> 5) + 16 * i;
                float q[8], k[8], oq[8], ok[8]; unpack8(rq[i], q); unpack8(rk[i], k);
#pragma unroll
                for (int j = 0; j < 8; ++j) { const float b = BL[t * 257 + c8 + j]; oq[j] = q[j] * 0.125f * __expf(b); ok[j] = k[j] * __expf(-b); }
                *(v4u*)(QG + (t0 + t) * 256 + c8) = pack8(oq); *(v4u*)(KG + (t0 + t) * 256 + c8) = pack8(ok);
            }
            if (tid < 256) EBL[(size_t)ci * 256 + tid] = __expf(BL[63 * 257 + tid]);
        }
        __syncthreads();
        KS[(size_t)ci * 512 + tid] = (KSP[tid] + KSP[512 + tid]) + (KSP[1024 + tid] + KSP[1536 + tid]);
        __syncthreads();
    }
}

__device__ __forceinline__ void mlstm_scalar(LAS unsigned char* lds, int b, int h, const bf16* QM, const bf16* KM, const bf16* U, const float* LI, const float* BF, const float* gnorm, bf16* HM) {
    const int tid = threadIdx.x;
    LAS bf16* qs = (LAS bf16*)lds;
    LAS bf16* ks = qs + 64 * 136;
    LAS bf16* vs = ks + 64 * 136;
    LAS float* Ss = (LAS float*)(lds + 52224);
    LAS float* Cs = (LAS float*)(lds + 68864);
    LAS float* ns = (LAS float*)(lds + 134400);
    LAS float* bs = ns + 128; LAS float* lis = bs + 64; LAS float* wint = lis + 64; LAS float* dinv = wint + 64; LAS float* wgs = dinv + 64;
    LAS float* hs = (LAS float*)lds;
    for (int i = tid; i < 128 * 128; i += 512) Cs[i] = 0.f;
    if (tid < 128) ns[tid] = 0.f;
    float m = 0.f;
    __syncthreads();
    for (int c = 0; c < 64; ++c) {
        const size_t t0 = (size_t)b * SEQ + (size_t)c * 64;
        for (int i = tid; i < 1024; i += 512) { const int t = i >> 4, cc = i & 15;
            *(LAS v4u*)(qs + t * 136 + cc * 8) = *(const v4u*)(QM + (t0 + t) * 512 + h * 128 + cc * 8);
            *(LAS v4u*)(ks + t * 136 + cc * 8) = *(const v4u*)(KM + (t0 + t) * 512 + h * 128 + cc * 8);
            *(LAS v4u*)(vs + t * 136 + cc * 8) = *(const v4u*)(U + (t0 + t) * NU + 1024 + h * 128 + cc * 8); }
        if (tid < 64) { bs[tid] = BF[(t0 + tid) * 4 + h]; lis[tid] = LI[(t0 + tid) * 4 + h]; }
        __syncthreads();
        { const int t = tid >> 3, sg = tid & 7;
            for (int i = 0; i < 8; ++i) { const int s = sg + 8 * i; if (s <= t) { float acc = 0.f; _Pragma("unroll 1") for (int d = 0; d < 128; ++d) acc += bf2f(qs[t * 136 + d]) * bf2f(ks[s * 136 + d]); Ss[t * 65 + s] = acc; } } }
        __syncthreads();
        if (tid < 64) { const int t = tid; const float bt = bs[t]; float mloc = bt + m;
            _Pragma("unroll 1") for (int s = 0; s <= t; ++s) mloc = fmaxf(mloc, bt - bs[s] + lis[s]);
            float rowsum = 0.f;
            _Pragma("unroll 1") for (int s = 0; s <= t; ++s) { const float v = Ss[t * 65 + s] * expf(bt - bs[s] + lis[s] - mloc); Ss[t * 65 + s] = v; rowsum += v; }
            const float wi = expf(bt + m - mloc); float qn = 0.f;
            _Pragma("unroll 1") for (int d = 0; d < 128; ++d) qn += bf2f(qs[t * 136 + d]) * ns[d];
            const float den = rowsum + wi * qn;
            dinv[t] = 1.0f / fmaxf(fabsf(den), expf(-mloc)); wint[t] = wi; }
        __syncthreads();
        { const int t = tid >> 3, j = tid & 7; float vals[16], qc[16];
#pragma unroll
            for (int k = 0; k < 16; ++k) { vals[k] = 0.f; qc[k] = 0.f; }
            _Pragma("unroll 1") for (int s = 0; s <= t; ++s) { const float sv = Ss[t * 65 + s];
#pragma unroll
                for (int k = 0; k < 16; ++k) vals[k] += sv * bf2f(vs[s * 136 + j * 16 + k]); }
            _Pragma("unroll 1") for (int d = 0; d < 128; ++d) { const float qd = bf2f(qs[t * 136 + d]);
#pragma unroll
                for (int k = 0; k < 16; ++k) qc[k] += qd * Cs[d * 128 + j * 16 + k]; }
            const float wi = wint[t], di = dinv[t]; float ss = 0.f;
#pragma unroll
            for (int k = 0; k < 16; ++k) { vals[k] = (vals[k] + wi * qc[k]) * di; ss += vals[k] * vals[k]; }
            ss += __shfl_xor(ss, 1); ss += __shfl_xor(ss, 2); ss += __shfl_xor(ss, 4);
            const float rstd = 1.0f / sqrtf(ss * (1.0f / 128.0f) + EPS);
#pragma unroll
            for (int k = 0; k < 16; ++k) { const int col = h * 128 + j * 16 + k; const float mo = bf2f(U[(t0 + t) * NU + 1536 + col]);
                HM[(t0 + t) * 1024 + col] = (bf16)f2bf(vals[k] * rstd * gnorm[col] * (1.0f / (1.0f + expf(-mo)))); } }
        __syncthreads();
        const float bL = bs[63]; float m_new = bL + m;
        _Pragma("unroll 1") for (int s = 0; s < 64; ++s) m_new = fmaxf(m_new, bL - bs[s] + lis[s]);
        const float decay = expf(bL + m - m_new);
        if (tid < 64) wgs[tid] = expf(bL - bs[tid] + lis[tid] - m_new);
        __syncthreads();
        { const int e = tid & 127, dg = tid >> 7;
            _Pragma("unroll 1") for (int dd = 0; dd < 32; ++dd) { const int d = dg * 32 + dd; float acc = decay * Cs[d * 128 + e];
                _Pragma("unroll 1") for (int s = 0; s < 64; ++s) acc += wgs[s] * bf2f(ks[s * 136 + d]) * bf2f(vs[s * 136 + e]);
                Cs[d * 128 + e] = acc; } }
        if (tid < 128) { const int d = tid; float acc = decay * ns[d]; _Pragma("unroll 1") for (int s = 0; s < 64; ++s) acc += wgs[s] * bf2f(ks[s * 136 + d]); ns[d] = acc; }
        m = m_new;
        __syncthreads();
    }
}
__device__ __forceinline__ void gla_scalar(LAS unsigned char* lds, int b, int h, const bf16* QG, const bf16* KG, const bf16* KW, const bf16* U, const float* EBL, const float* gnorm, bf16* HM) {
    const int tid = threadIdx.x;
    LAS bf16* qg = (LAS bf16*)lds;
    LAS bf16* kg = qg + 64 * 72; LAS bf16* kw = kg + 64 * 72;
    LAS bf16* vs = kw + 64 * 72;
    LAS float* As = (LAS float*)(lds + 45056);
    LAS float* St = (LAS float*)(lds + 61696);
    LAS float* ebl = (LAS float*)(lds + 94464);
    LAS float* hs = (LAS float*)lds;
    for (int i = tid; i < 64 * 128; i += 512) St[i] = 0.f;
    __syncthreads();
    for (int c = 0; c < 64; ++c) {
        const size_t t0 = (size_t)b * SEQ + (size_t)c * 64;
        { const int t = tid >> 3, cc = tid & 7;
            *(LAS v4u*)(qg + t * 72 + cc * 8) = *(const v4u*)(QG + (t0 + t) * 256 + h * 64 + cc * 8);
            *(LAS v4u*)(kg + t * 72 + cc * 8) = *(const v4u*)(KG + (t0 + t) * 256 + h * 64 + cc * 8);
            *(LAS v4u*)(kw + t * 72 + cc * 8) = *(const v4u*)(KW + (t0 + t) * 256 + h * 64 + cc * 8); }
        for (int i = tid; i < 1024; i += 512) { const int t = i >> 4, cc = i & 15; *(LAS v4u*)(vs + t * 136 + cc * 8) = *(const v4u*)(U + (t0 + t) * NU + 2560 + h * 128 + cc * 8); }
        if (tid < 64) ebl[tid] = EBL[((size_t)b * 64 + c) * 256 + h * 64 + tid];
        __syncthreads();
        { const int t = tid >> 3, sg = tid & 7;
            for (int i = 0; i < 8; ++i) { const int s = sg + 8 * i; if (s <= t) { float acc = 0.f; _Pragma("unroll 1") for (int d = 0; d < 64; ++d) acc += bf2f(qg[t * 72 + d]) * bf2f(kg[s * 72 + d]); As[t * 65 + s] = acc; } } }
        __syncthreads();
        { const int t = tid >> 3, j = tid & 7; float vals[16];
#pragma unroll
            for (int k = 0; k < 16; ++k) vals[k] = 0.f;
            _Pragma("unroll 1") for (int s = 0; s <= t; ++s) { const float sv = As[t * 65 + s];
#pragma unroll
                for (int k = 0; k < 16; ++k) vals[k] += sv * bf2f(vs[s * 136 + j * 16 + k]); }
            _Pragma("unroll 1") for (int d = 0; d < 64; ++d) { const float qd = bf2f(qg[t * 72 + d]);
#pragma unroll
                for (int k = 0; k < 16; ++k) vals[k] += qd * St[d * 128 + j * 16 + k]; }
            float ss = 0.f;
#pragma unroll
            for (int k = 0; k < 16; ++k) ss += vals[k] * vals[k];
            ss += __shfl_xor(ss, 1); ss += __shfl_xor(ss, 2); ss += __shfl_xor(ss, 4);
            const float rstd = 1.0f / sqrtf(ss * (1.0f / 128.0f) + EPS);
#pragma unroll
            for (int k = 0; k < 16; ++k) { const int col = h * 128 + j * 16 + k; const float gr = bf2f(U[(t0 + t) * NU + 3072 + col]);
                HM[(t0 + t) * 1024 + 512 + col] = (bf16)f2bf(vals[k] * rstd * gnorm[col] * (gr / (1.0f + expf(-gr)))); } }
        __syncthreads();
        { const int e = tid & 127, dg = tid >> 7;
            _Pragma("unroll 1") for (int dd = 0; dd < 16; ++dd) { const int d = dg * 16 + dd; float acc = ebl[d] * St[d * 128 + e];
                _Pragma("unroll 1") for (int s = 0; s < 64; ++s) acc += bf2f(kw[s * 72 + d]) * bf2f(vs[s * 136 + e]);
                St[d * 128 + e] = acc; } }
        __syncthreads();
    }
}
__device__ __forceinline__ void phase_mixers_scalar(const Args& a, LAS unsigned char* lds, int G) {
    unsigned char* ws = a.ws;
    for (int w = blockIdx.x; w < 128; w += G) {
        if (w < 64) mlstm_scalar(lds, w >> 2, w & 3, (const bf16*)(ws + WS_QM), (const bf16*)(ws + WS_KM), (const bf16*)(ws + WS_U), (const float*)(ws + WS_LI), (const float*)(ws + WS_BF), a.in[I_MNG], (bf16*)(ws + WS_HM));
        else gla_scalar(lds, (w - 64) >> 2, (w - 64) & 3, (const bf16*)(ws + WS_QG), (const bf16*)(ws + WS_KG), (const bf16*)(ws + WS_KW), (const bf16*)(ws + WS_U), (const float*)(ws + WS_EBL), a.in[I_GNG], (bf16*)(ws + WS_HM));
        __syncthreads();
    }
}
__device__ __forceinline__ void phase_softmax(const float* SC, bf16* P, int G) {
    const int lane = threadIdx.x & 63, wave = threadIdx.x >> 6, gw = blockIdx.x * NWAVES + wave, NGW = G * NWAVES;
    for (int r = gw; r < T * 4; r += NGW) {
        const f32x4 v = *((const f32x4*)(SC + (size_t)r * 256) + lane);
        const float mx = wave_max(fmaxf(fmaxf(v.x, v.y), fmaxf(v.z, v.w)));
        const float e0 = expf(v.x - mx), e1 = expf(v.y - mx), e2 = expf(v.z - mx), e3 = expf(v.w - mx);
        const float inv = 1.0f / wave_sum((e0 + e1) + (e2 + e3));
        *((v2u*)(P + (size_t)r * 256) + lane) = (v2u){pk2(e0 * inv, e1 * inv), pk2(e2 * inv, e3 * inv)};
    }
}
__device__ __forceinline__ void phase_final(float* out, const float* ssp, const float* g, int G) {
    const int lane = threadIdx.x & 63, wave = threadIdx.x >> 6, gw = blockIdx.x * NWAVES + wave, NGW = G * NWAVES;
    f32x4 gv[4];
#pragma unroll
    for (int j = 0; j < 4; ++j) gv[j] = ((const f32x4*)g)[lane + 64 * j];
    for (int m = gw; m < T; m += NGW) {
        const float s = wave_sum(lane < 16 ? ssp[(size_t)m * 16 + lane] : 0.f);
        const float rs = 1.0f / sqrtf(s * (1.0f / DM) + EPS);
        f32x4* xr = (f32x4*)(out + (size_t)m * DM) + lane;
#pragma unroll
        for (int j = 0; j < 4; ++j) { f32x4 v = xr[64 * j]; xr[64 * j] = v * rs * gv[j]; }
    }
}

typedef short bf16x8 __attribute__((ext_vector_type(8)));
typedef short s16x4 __attribute__((ext_vector_type(4)));
#define MFMA16(x, y, acc) __builtin_amdgcn_mfma_f32_16x16x32_bf16((x), (y), (acc), 0, 0, 0)
__device__ __forceinline__ bf16x8 frag_n(const LAS bf16* base, int LD, int r0, int k0, int lane) { return *(const LAS bf16x8*)(base + (r0 + (lane & 15)) * LD + k0 + 8 * (lane >> 4)); }
__device__ __forceinline__ bf16x8 frag_t(const LAS bf16* base, int LD, int k0, int n0, int lane) {
    const int g = lane >> 4, q = (lane & 15) >> 2, p = lane & 3;
    const LAS bf16* a0 = base + (k0 + 8 * g + q) * LD + n0 + 4 * p;
    const s16x4 lo = __builtin_bit_cast(s16x4, __builtin_amdgcn_ds_read_tr16_b64_v4i16((LAS s16x4*)a0));
    const s16x4 hi = __builtin_bit_cast(s16x4, __builtin_amdgcn_ds_read_tr16_b64_v4i16((LAS s16x4*)(a0 + 4 * LD)));
    return __builtin_shufflevector(lo, hi, 0, 1, 2, 3, 4, 5, 6, 7);
}


__device__ __forceinline__ void phase_chain(const Args& a, LAS unsigned char* lds, int G) {
    const int tid = threadIdx.x, lane = tid & 63, w = __builtin_amdgcn_readfirstlane(tid >> 6), g = lane >> 4;
    unsigned char* ws = a.ws;
    const bf16* U = (const bf16*)(ws + WS_U); const bf16* KM = (const bf16*)(ws + WS_KM); const bf16* KG = (const bf16*)(ws + WS_KG);
    bf16* CT = (bf16*)(ws + WS_CT); bf16* ST = (bf16*)((unsigned char*)a.out + DO_ST);
    float* NST = (float*)(ws + WS_NST); float* MST = (float*)(ws + WS_MST);
    const float* KS = (const float*)(ws + WS_KS); const float* BLM = (const float*)(ws + WS_BLM); const float* GMX = (const float*)(ws + WS_GMX); const float* EBL = (const float*)(ws + WS_EBL); const float* WG = (const float*)(ws + WS_WG);
    const int bx = blockIdx.x, vcu = (G % 8 == 0) ? (bx % 8) * (G / 8) + bx / 8 : bx;
    constexpr int BUF = 36864, O_KM = 0, O_KG = 17408, O_VM = 26624, O_VG = 31744;
    for (int wk = vcu; wk < 256; wk += G) {
        const int bh = wk >> 2, q = wk & 3, b = bh >> 2, h = bh & 3;
        const bf16* km_g = KM + (size_t)b * SEQ * 512 + h * 128;
        const bf16* kg_g = KG + (size_t)b * SEQ * 256 + h * 64;
        const bool vm = tid < 256;
        const bf16* v_g = U + (size_t)b * SEQ * NU + (vm ? 1024 + h * 128 + 32 * q : 2560 + h * 128 + 32 * q);
        const float* wg_g = WG + (size_t)b * SEQ * 4 + h;
        const int r01 = tid >> 4, c01 = (tid & 15) * 8, r2 = tid >> 3, c2 = (tid & 7) * 8, r3 = (tid & 255) >> 2, c3 = (tid & 3) * 8;
        f32x4 cm[2] = {{0.f, 0.f, 0.f, 0.f}, {0.f, 0.f, 0.f, 0.f}}, cgs = {0.f, 0.f, 0.f, 0.f};
        float m = 0.f, nreg = 0.f;
        v4u pa0, pa1, pa2, pa3, pb0, pb1, pb2, pb3, pc0, pc1, pc2, pc3, pd0, pd1, pd2, pd3; float wa = 1.f, wb = 1.f, wc = 1.f, wd = 1.f;
        f32x4 ea = {0.f, 0.f, 0.f, 0.f}, eb2 = ea, ec = ea, ed = ea, e_cur, e_nxt = ea; float ka = 0.f, kb2 = 0.f, kc = 0.f, kd = 0.f, k_cur, k_nxt = 0.f;
        const float bl_all = BLM[(b * 64 + lane) * 4 + h], gm_all = GMX[(b * 64 + lane) * 4 + h];
        const float* ebl_g = EBL + (size_t)b * 64 * 256 + h * 64 + 16 * (w & 3) + 4 * g; const float* ks_g = KS + (size_t)b * 64 * 512 + h * 128 + (tid & 127);
#define CH_LOAD(P0, P1, P2, P3, WV, EV, KV, cc_) do { EV = *(const f32x4*)(ebl_g + (size_t)(cc_) * 256); KV = ks_g[(size_t)(cc_) * 512]; const size_t t1_ = (size_t)(cc_) * 64; \
            P0 = *(const v4u*)(km_g + (t1_ + r01) * 512 + c01); P1 = *(const v4u*)(km_g + (t1_ + r01 + 32) * 512 + c01); \
            P2 = *(const v4u*)(kg_g + (t1_ + r2) * 256 + c2); P3 = *(const v4u*)(v_g + (t1_ + r3) * NU + c3); WV = wg_g[(t1_ + r3) * 4]; } while (0)
#define CH_STAGE(P0, P1, P2, P3, WV, cc_) do { LAS unsigned char* Bn_ = lds + ((cc_) & 1) * BUF; \
            *(LAS v4u*)(Bn_ + O_KM + (r01 * 136 + c01) * 2) = P0; *(LAS v4u*)(Bn_ + O_KM + ((r01 + 32) * 136 + c01) * 2) = P1; \
            *(LAS v4u*)(Bn_ + O_KG + (r2 * 72 + c2) * 2) = P2; \
            { float v8_[8]; unpack8(P3, v8_); const float ws_ = vm ? WV : 1.0f; _Pragma("unroll") for (int i_ = 0; i_ < 8; ++i_) v8_[i_] *= ws_; *(LAS v4u*)(Bn_ + (vm ? O_VM : O_VG) + (r3 * 40 + c3) * 2) = pack8(v8_); } } while (0)
#define CH_STEP(cc_) do { const int c_ = (cc_); \
            const float bL = __shfl(bl_all, c_), gmx = __shfl(gm_all, c_); \
            const f32x4 eb = e_cur; \
            const float ksv = (q == 0 && tid < 128) ? k_cur : 0.f; \
            const LAS unsigned char* Bf = lds + (c_ & 1) * BUF; \
            f32x4 pm0 = {0.f, 0.f, 0.f, 0.f}, pm1 = {0.f, 0.f, 0.f, 0.f}; \
            _Pragma("unroll") for (int ks = 0; ks < 2; ++ks) { \
                const bf16x8 xa = frag_t((const LAS bf16*)(Bf + O_KM), 136, 32 * ks, 16 * w, lane); \
                const bf16x8 y0 = frag_t((const LAS bf16*)(Bf + O_VM), 40, 32 * ks, 0, lane), y1 = frag_t((const LAS bf16*)(Bf + O_VM), 40, 32 * ks, 16, lane); \
                pm0 = MFMA16(xa, y0, pm0); pm1 = MFMA16(xa, y1, pm1); \
                const bf16x8 xg = frag_t((const LAS bf16*)(Bf + O_KG), 72, 32 * ks, 16 * (w & 3), lane); \
                const bf16x8 yg = frag_t((const LAS bf16*)(Bf + O_VG), 40, 32 * ks, 16 * (w >> 2), lane); \
                cgs = MFMA16(xg, yg, cgs); } \
            const float m_new = fmaxf(bL + m, gmx), decay = __expf(bL + m - m_new), scale2 = __expf(gmx - m_new); \
            cm[0] = cm[0] * decay + pm0 * scale2; cm[1] = cm[1] * decay + pm1 * scale2; cgs = cgs * eb; \
            nreg = nreg * decay + ksv * scale2; m = m_new; } while (0)
#define CH_STORE(cc_) do { const int it_ = (b * 64 + (cc_)) * 4 + h; \
            _Pragma("unroll") for (int j = 0; j < 2; ++j) *(v2u*)(CT + ((size_t)it_ * 128 + 32 * q + 16 * j + (lane & 15)) * 128 + 16 * w + 4 * g) = (v2u){pg8::cvt_pk_bf16(cm[j][0], cm[j][1]), pg8::cvt_pk_bf16(cm[j][2], cm[j][3])}; \
            *(v2u*)(ST + ((size_t)it_ * 128 + 32 * q + 16 * (w >> 2) + (lane & 15)) * 64 + 16 * (w & 3) + 4 * g) = (v2u){pg8::cvt_pk_bf16(cgs[0], cgs[1]), pg8::cvt_pk_bf16(cgs[2], cgs[3])}; \
            if (q == 0) { if (tid < 128) NST[(size_t)it_ * 128 + tid] = nreg; if (tid == 0) MST[it_] = m; } } while (0)
        CH_LOAD(pa0, pa1, pa2, pa3, wa, e_cur, k_cur, 0); CH_STAGE(pa0, pa1, pa2, pa3, wa, 0);
        CH_LOAD(pb0, pb1, pb2, pb3, wb, eb2, kb2, 1); CH_LOAD(pc0, pc1, pc2, pc3, wc, ec, kc, 2); CH_LOAD(pd0, pd1, pd2, pd3, wd, ed, kd, 3);
#define CH_ITER(cc_, S0, S1, S2, S3, SW, SE, SK, L0, L1, L2, L3, LW, LE, LK) \
            CH_STORE(cc_); if ((cc_) == 63) break; \
            __syncthreads(); \
            CH_STAGE(S0, S1, S2, S3, SW, (cc_) + 1); e_nxt = SE; k_nxt = SK; \
            if ((cc_) + 4 < 63) CH_LOAD(L0, L1, L2, L3, LW, LE, LK, (cc_) + 4); \
            CH_STEP(cc_); e_cur = e_nxt; k_cur = k_nxt;
        for (int c = 0; c < 64; c += 4) {
            CH_ITER(c,     pb0, pb1, pb2, pb3, wb, eb2, kb2, pa0, pa1, pa2, pa3, wa, ea, ka)
            CH_ITER(c + 1, pc0, pc1, pc2, pc3, wc, ec, kc,  pb0, pb1, pb2, pb3, wb, eb2, kb2)
            CH_ITER(c + 2, pd0, pd1, pd2, pd3, wd, ed, kd,  pc0, pc1, pc2, pc3, wc, ec, kc)
            CH_ITER(c + 3, pa0, pa1, pa2, pa3, wa, ea, ka,  pd0, pd1, pd2, pd3, wd, ed, kd)
        }
#undef CH_ITER
#undef CH_LOAD
#undef CH_STAGE
#undef CH_STEP
#undef CH_STORE
        __syncthreads();
    }
}

__device__ __forceinline__ bf16x8 frag_tp(const LAS bf16* base, int LD, int k0, int n0, int lane) {
    const int g = lane >> 4, q = (lane & 15) >> 2, p = lane & 3;
    const LAS bf16* a0 = base + (k0 + 4 * g + q) * LD + n0 + 4 * p;
    const s16x4 lo = __builtin_bit_cast(s16x4, __builtin_amdgcn_ds_read_tr16_b64_v4i16((LAS s16x4*)a0));
    const s16x4 hi = __builtin_bit_cast(s16x4, __builtin_amdgcn_ds_read_tr16_b64_v4i16((LAS s16x4*)(a0 + 16 * LD)));
    return __builtin_shufflevector(lo, hi, 0, 1, 2, 3, 4, 5, 6, 7);
}
__device__ __forceinline__ bf16x8 pack_acc2(const f32x4 a, const f32x4 b) {
    const v4u u = {pg8::cvt_pk_bf16(a[0], a[1]), pg8::cvt_pk_bf16(a[2], a[3]), pg8::cvt_pk_bf16(b[0], b[1]), pg8::cvt_pk_bf16(b[2], b[3])};
    return __builtin_bit_cast(bf16x8, u);
}
struct MlstmPre { v4u rk[4], rv[4], rc[8]; float bsv, liv, nv; };
struct MixPtrs { const bf16* QM; const bf16* KM; const bf16* U; const float* LI; const float* BF; const float* MXP; const bf16* CT; const float* NST; const float* MST; const float* gnorm; bf16* HM;
                 const bf16* QG; const bf16* KG; const bf16* ST; const float* gnorm_g; };
__device__ __forceinline__ void mlstm_load(MlstmPre& P, const MixPtrs& M, int item, int tt, int lane, int ht) {
    const int g = lane >> 4, h = item & 3, bc = item >> 2, b = bc >> 6, c = bc & 63; const size_t t0 = (size_t)b * SEQ + (size_t)c * 64; const int t = 16 * tt + (lane & 15);
#pragma unroll
    for (int j = 0; j < 4; ++j) { const int i = ht + 256 * j, r = i >> 4, cc = (i & 15) * 8; P.rk[j] = *(const v4u*)(M.KM + (t0 + r) * 512 + h * 128 + cc); P.rv[j] = *(const v4u*)(M.U + (t0 + r) * NU + 1024 + h * 128 + cc); }
#pragma unroll
    for (int j = 0; j < 8; ++j) { const int i = ht + 256 * j, e = i >> 4, cc = (i & 15) * 8; P.rc[j] = *(const v4u*)(M.CT + ((size_t)item * 128 + e) * 128 + cc); }
    P.bsv = M.BF[(t0 + (ht & 63)) * 4 + h]; P.liv = M.LI[(t0 + (ht & 63)) * 4 + h]; P.nv = M.NST[(size_t)item * 128 + (ht & 127)];
}
__device__ __forceinline__ void mlstm_pairs(LAS unsigned char* lds, int first, int stride, const MixPtrs& M) {
    const int tid = threadIdx.x, lane = tid & 63, w = __builtin_amdgcn_readfirstlane(tid >> 6), g = lane >> 4, half = w >> 2, tt = w & 3, ht = tid & 255;
    constexpr int ITEM = 76544;
    LAS unsigned char* L = lds + half * ITEM;
    LAS bf16* Ks = (LAS bf16*)L;
    LAS bf16* Vs = (LAS bf16*)(L + 17408);
    LAS bf16* Cts = (LAS bf16*)(L + 36864);
    LAS float* bs = (LAS float*)(L + 76032); LAS float* lis = bs + 64;
    if (first >= 2048) return;
    MlstmPre P; mlstm_load(P, M, 2 * first + half, tt, lane, ht);
    if (ht < 64) { *(LAS v4u*)(Vs + ht * 152 + 128) = (v4u){0x00003F80u, 0u, 0u, 0u}; *(LAS v4u*)(Vs + ht * 152 + 136) = (v4u){0u, 0u, 0u, 0u}; }
    if (ht < 240) { const int e = 129 + (ht >> 4), cc = (ht & 15) * 8; *(LAS v4u*)(Cts + e * 136 + cc) = (v4u){0u, 0u, 0u, 0u}; }
    for (int p = first; p < 2048; p += stride) {
        const int item = 2 * p + half, h = item & 3, bc = item >> 2, b = bc >> 6, c = bc & 63;
        const size_t t0 = (size_t)b * SEQ + (size_t)c * 64;
        const int t = 16 * tt + (lane & 15);
        bf16x8 yq[4];
#pragma unroll
        for (int ks = 0; ks < 4; ++ks) yq[ks] = *(const bf16x8*)(M.QM + (t0 + t) * 512 + h * 128 + 32 * ks + 8 * g);
        const float b_t = M.BF[(t0 + t) * 4 + h], mx_t = M.MXP[(t0 + t) * 4 + h], m_c = M.MST[item];
#pragma unroll
        for (int j = 0; j < 4; ++j) { const int i = ht + 256 * j, r = i >> 4, cc = (i & 15) * 8; *(LAS v4u*)(Ks + r * 136 + cc) = P.rk[j]; *(LAS v4u*)(Vs + r * 152 + cc) = P.rv[j]; }
#pragma unroll
        for (int j = 0; j < 8; ++j) { const int i = ht + 256 * j, e = i >> 4, cc = (i & 15) * 8; *(LAS v4u*)(Cts + e * 136 + cc) = P.rc[j]; }
        if (ht < 64) { bs[ht] = P.bsv; lis[ht] = P.liv; }
        if (ht < 128) Cts[128 * 136 + ht] = (bf16)f2bf(P.nv);
        __syncthreads();
        if (p + stride < 2048) mlstm_load(P, M, 2 * (p + stride) + half, tt, lane, ht);
        v2u mo[8];
#pragma unroll
        for (int et = 0; et < 8; ++et) mo[et] = *(const v2u*)(M.U + (t0 + t) * NU + 1536 + h * 128 + 16 * et + 4 * g);
        const float mt = b_t + fmaxf(mx_t, m_c), wi = __expf(b_t + m_c - mt);
        f32x4 sa[4];
#pragma unroll
        for (int si = 0; si < 4; ++si) { sa[si] = (f32x4){0.f, 0.f, 0.f, 0.f};
            if (si <= tt) {
#pragma unroll
                for (int ks = 0; ks < 4; ++ks) sa[si] = MFMA16(frag_n(Ks, 136, 16 * si, 32 * ks, lane), yq[ks], sa[si]);
#pragma unroll
                for (int r = 0; r < 4; ++r) { const int s = 16 * si + 4 * g + r; sa[si][r] = (s <= t) ? sa[si][r] * __expf(b_t - bs[s] + lis[s] - mt) : 0.f; }
            } }
        const bf16x8 ys0 = pack_acc2(sa[0], sa[1]), ys1 = pack_acc2(sa[2], sa[3]);
        f32x4 num[9];
#pragma unroll
        for (int et = 0; et < 9; ++et) { f32x4 a1 = {0.f, 0.f, 0.f, 0.f}, a2 = {0.f, 0.f, 0.f, 0.f};
            a1 = MFMA16(frag_tp(Vs, 152, 0, 16 * et, lane), ys0, a1);
            if (tt >= 2) a1 = MFMA16(frag_tp(Vs, 152, 32, 16 * et, lane), ys1, a1);
#pragma unroll
            for (int ks = 0; ks < 4; ++ks) a2 = MFMA16(frag_n(Cts, 136, 16 * et, 32 * ks, lane), yq[ks], a2);
            num[et] = a1 + a2 * wi; }
        const float den = __shfl(num[8][0], lane & 15), dinv = 1.0f / fmaxf(fabsf(den), __expf(-mt));
        float ss = 0.f;
#pragma unroll
        for (int et = 0; et < 8; ++et) { num[et] = num[et] * dinv; ss += (num[et][0] * num[et][0] + num[et][1] * num[et][1]) + (num[et][2] * num[et][2] + num[et][3] * num[et][3]); }
        ss += __shfl_xor(ss, 16); ss += __shfl_xor(ss, 32);
        const float rstd = 1.0f / sqrtf(ss * (1.0f / 128.0f) + EPS);
#pragma unroll
        for (int et = 0; et < 8; ++et) { const int col = h * 128 + 16 * et + 4 * g; const f32x4 gn = *(const f32x4*)(M.gnorm + col);
            const float m0 = pg8::bf_lo(mo[et].x), m1 = pg8::bf_hi(mo[et].x), m2 = pg8::bf_lo(mo[et].y), m3 = pg8::bf_hi(mo[et].y);
            const float o0 = num[et][0] * rstd * gn[0] * __builtin_amdgcn_rcpf(1.0f + __expf(-m0)), o1 = num[et][1] * rstd * gn[1] * __builtin_amdgcn_rcpf(1.0f + __expf(-m1));
            const float o2 = num[et][2] * rstd * gn[2] * __builtin_amdgcn_rcpf(1.0f + __expf(-m2)), o3 = num[et][3] * rstd * gn[3] * __builtin_amdgcn_rcpf(1.0f + __expf(-m3));
            *(v2u*)(M.HM + (t0 + t) * 1024 + col) = (v2u){pg8::cvt_pk_bf16(o0, o1), pg8::cvt_pk_bf16(o2, o3)}; }
        __syncthreads();
    }
}
struct GlaPre { v4u rk[2], rv[4], rs[4]; };
__device__ __forceinline__ void gla_load(GlaPre& P, const MixPtrs& M, int item, int tt, int lane, int ht) {
    const int g = lane >> 4, h = item & 3, bc = item >> 2, b = bc >> 6, c = bc & 63; const size_t t0 = (size_t)b * SEQ + (size_t)c * 64; const int t = 16 * tt + (lane & 15);
#pragma unroll
    for (int j = 0; j < 2; ++j) { const int i = ht + 256 * j, r = i >> 3, cc = (i & 7) * 8; P.rk[j] = *(const v4u*)(M.KG + (t0 + r) * 256 + h * 64 + cc); }
#pragma unroll
    for (int j = 0; j < 4; ++j) { const int i = ht + 256 * j, r = i >> 4, cc = (i & 15) * 8; P.rv[j] = *(const v4u*)(M.U + (t0 + r) * NU + 2560 + h * 128 + cc); }
#pragma unroll
    for (int j = 0; j < 4; ++j) { const int i = ht + 256 * j, e = i >> 3, cc = (i & 7) * 8; P.rs[j] = *(const v4u*)(M.ST + ((size_t)item * 128 + e) * 64 + cc); }
}
__device__ __forceinline__ void gla_pairs(LAS unsigned char* lds, int first, int stride, const MixPtrs& M) {
    const int tid = threadIdx.x, lane = tid & 63, w = __builtin_amdgcn_readfirstlane(tid >> 6), g = lane >> 4, half = w >> 2, tt = w & 3, ht = tid & 255;
    constexpr int ITEM = 45056;
    LAS unsigned char* L = lds + half * ITEM;
    LAS bf16* Kg = (LAS bf16*)L;
    LAS bf16* Vs = (LAS bf16*)(L + 9216);
    LAS bf16* Sts = (LAS bf16*)(L + 26624);
    if (first >= 2048) return;
    GlaPre P; gla_load(P, M, 2 * first + half, tt, lane, ht);
    for (int p = first; p < 2048; p += stride) {
        const int item = 2 * p + half, h = item & 3, bc = item >> 2, b = bc >> 6, c = bc & 63;
        const size_t t0 = (size_t)b * SEQ + (size_t)c * 64;
        const int t = 16 * tt + (lane & 15);
        bf16x8 yq[2];
#pragma unroll
        for (int ks = 0; ks < 2; ++ks) yq[ks] = *(const bf16x8*)(M.QG + (t0 + t) * 256 + h * 64 + 32 * ks + 8 * g);
#pragma unroll
        for (int j = 0; j < 2; ++j) { const int i = ht + 256 * j, r = i >> 3, cc = (i & 7) * 8; *(LAS v4u*)(Kg + r * 72 + cc) = P.rk[j]; }
#pragma unroll
        for (int j = 0; j < 4; ++j) { const int i = ht + 256 * j, r = i >> 4, cc = (i & 15) * 8; *(LAS v4u*)(Vs + r * 136 + cc) = P.rv[j]; }
#pragma unroll
        for (int j = 0; j < 4; ++j) { const int i = ht + 256 * j, e = i >> 3, cc = (i & 7) * 8; *(LAS v4u*)(Sts + e * 72 + cc) = P.rs[j]; }
        __syncthreads();
        if (p + stride < 2048) gla_load(P, M, 2 * (p + stride) + half, tt, lane, ht);
        v2u gr[8];
#pragma unroll
        for (int et = 0; et < 8; ++et) gr[et] = *(const v2u*)(M.U + (t0 + t) * NU + 3072 + h * 128 + 16 * et + 4 * g);
        f32x4 sa[4];
#pragma unroll
        for (int si = 0; si < 4; ++si) { sa[si] = (f32x4){0.f, 0.f, 0.f, 0.f};
            if (si <= tt) {
#pragma unroll
                for (int ks = 0; ks < 2; ++ks) sa[si] = MFMA16(frag_n(Kg, 72, 16 * si, 32 * ks, lane), yq[ks], sa[si]);
#pragma unroll
                for (int r = 0; r < 4; ++r) { const int s = 16 * si + 4 * g + r; sa[si][r] = (s <= t) ? sa[si][r] : 0.f; }
            } }
        const bf16x8 ys0 = pack_acc2(sa[0], sa[1]), ys1 = pack_acc2(sa[2], sa[3]);
        f32x4 num[8]; float ss = 0.f;
#pragma unroll
        for (int et = 0; et < 8; ++et) { f32x4 a1 = {0.f, 0.f, 0.f, 0.f};
            a1 = MFMA16(frag_tp(Vs, 136, 0, 16 * et, lane), ys0, a1);
            if (tt >= 2) a1 = MFMA16(frag_tp(Vs, 136, 32, 16 * et, lane), ys1, a1);
#pragma unroll
            for (int ks = 0; ks < 2; ++ks) a1 = MFMA16(frag_n(Sts, 72, 16 * et, 32 * ks, lane), yq[ks], a1);
            num[et] = a1; ss += (a1[0] * a1[0] + a1[1] * a1[1]) + (a1[2] * a1[2] + a1[3] * a1[3]); }
        ss += __shfl_xor(ss, 16); ss += __shfl_xor(ss, 32);
        const float rstd = 1.0f / sqrtf(ss * (1.0f / 128.0f) + EPS);
#pragma unroll
        for (int et = 0; et < 8; ++et) { const int col = h * 128 + 16 * et + 4 * g; const f32x4 gn = *(const f32x4*)(M.gnorm_g + col);
            const float m0 = pg8::bf_lo(gr[et].x), m1 = pg8::bf_hi(gr[et].x), m2 = pg8::bf_lo(gr[et].y), m3 = pg8::bf_hi(gr[et].y);
            const float o0 = num[et][0] * rstd * gn[0] * m0 * __builtin_amdgcn_rcpf(1.0f + __expf(-m0)), o1 = num[et][1] * rstd * gn[1] * m1 * __builtin_amdgcn_rcpf(1.0f + __expf(-m1));
            const float o2 = num[et][2] * rstd * gn[2] * m2 * __builtin_amdgcn_rcpf(1.0f + __expf(-m2)), o3 = num[et][3] * rstd * gn[3] * m3 * __builtin_amdgcn_rcpf(1.0f + __expf(-m3));
            *(v2u*)(M.HM + (t0 + t) * 1024 + 512 + col) = (v2u){pg8::cvt_pk_bf16(o0, o1), pg8::cvt_pk_bf16(o2, o3)}; }
        __syncthreads();
    }
}
__device__ __forceinline__ void phase_mixout(const Args& a, LAS unsigned char* lds, int G) {
    unsigned char* ws = a.ws;
    const MixPtrs M{(const bf16*)(ws + WS_QM), (const bf16*)(ws + WS_KM), (const bf16*)(ws + WS_U), (const float*)(ws + WS_LI), (const float*)(ws + WS_BF), (const float*)(ws + WS_MXP),
                    (const bf16*)(ws + WS_CT), (const float*)(ws + WS_NST), (const float*)(ws + WS_MST), a.in[I_MNG], (bf16*)(ws + WS_HM),
                    (const bf16*)(ws + WS_QG), (const bf16*)(ws + WS_KG), (const bf16*)((const unsigned char*)a.out + DO_ST), a.in[I_GNG]};
    mlstm_pairs(lds, blockIdx.x, G, M);
    __syncthreads();
    gla_pairs(lds, blockIdx.x, G, M);
}

__device__ __forceinline__ void phase_attn(const bf16* HQ, const bf16* KB, const bf16* VT, bf16* ATT, LAS unsigned char* lds, int G) {
    const int tid = threadIdx.x, lane = tid & 63, w = __builtin_amdgcn_readfirstlane(tid >> 6), g = lane >> 4;
    LAS bf16* Ls = (LAS bf16*)lds;
    constexpr int LD = 264;
    const int bx = blockIdx.x, vcu = (G % 8 == 0) ? (bx % 8) * (G / 8) + bx / 8 : bx;
    for (int u = vcu; u < 1024; u += G) {
        const int tile = u & 15, bh = u >> 4, b = bh >> 2, h = bh & 3;
        const size_t tok0 = (size_t)b * SEQ + (size_t)tile * 256 + 32 * w;
        { v4u rr[16];
#pragma unroll
          for (int j = 0; j < 16; ++j) { const int i = tid + 512 * j, r = i >> 5, cc = (i & 31) * 8; rr[j] = *(const v4u*)(KB + ((size_t)b * 256 + r) * 1024 + h * 256 + cc); }
#pragma unroll
          for (int j = 0; j < 16; ++j) { const int i = tid + 512 * j, r = i >> 5, cc = (i & 31) * 8; *(LAS v4u*)(Ls + r * LD + cc) = rr[j]; } }
        __syncthreads();
        bf16x8 yp[2][8]; float inv[2];
#pragma unroll
        for (int rt = 0; rt < 2; ++rt) {
            const size_t trow = tok0 + 16 * rt + (lane & 15);
            bf16x8 yq[8];
#pragma unroll
            for (int ks = 0; ks < 8; ++ks) yq[ks] = *(const bf16x8*)(HQ + trow * 1024 + h * 256 + 32 * ks + 8 * g);
            f32x4 sa[16];
#pragma unroll
            for (int kt = 0; kt < 16; ++kt) { sa[kt] = (f32x4){0.f, 0.f, 0.f, 0.f};
#pragma unroll
                for (int ks = 0; ks < 8; ++ks) sa[kt] = MFMA16(frag_n(Ls, LD, 16 * kt, 32 * ks, lane), yq[ks], sa[kt]); }
            float mx = -3.0e38f;
#pragma unroll
            for (int kt = 0; kt < 16; ++kt) mx = fmaxf(mx, fmaxf(fmaxf(sa[kt][0], sa[kt][1]), fmaxf(sa[kt][2], sa[kt][3])));
            mx = fmaxf(mx, __shfl_xor(mx, 16)); mx = fmaxf(mx, __shfl_xor(mx, 32));
            float sum = 0.f;
#pragma unroll
            for (int kt = 0; kt < 16; ++kt) {
#pragma unroll
                for (int r = 0; r < 4; ++r) { sa[kt][r] = __expf(sa[kt][r] - mx); sum += sa[kt][r]; } }
            sum += __shfl_xor(sum, 16); sum += __shfl_xor(sum, 32);
            inv[rt] = 1.0f / sum;
#pragma unroll
            for (int ks = 0; ks < 8; ++ks) yp[rt][ks] = pack_acc2(sa[2 * ks], sa[2 * ks + 1]);
        }
        __syncthreads();
        { v4u rr[16];
#pragma unroll
          for (int j = 0; j < 16; ++j) { const int i = tid + 512 * j, r = i >> 5, cc = (i & 31) * 8; rr[j] = *(const v4u*)(VT + ((size_t)h * 256 + r) * 4096 + (size_t)b * 256 + cc); }
#pragma unroll
          for (int j = 0; j < 16; ++j) { const int i = tid + 512 * j, r = i >> 5, cc = (i & 31) * 8; *(LAS v4u*)(Ls + r * LD + cc) = rr[j]; } }
        __syncthreads();
#pragma unroll
        for (int rt = 0; rt < 2; ++rt) {
            const size_t trow = tok0 + 16 * rt + (lane & 15);
#pragma unroll
            for (int hh = 0; hh < 16; ++hh) { f32x4 o = {0.f, 0.f, 0.f, 0.f};
                const LAS bf16* vr = Ls + (16 * hh + (lane & 15)) * LD + 4 * g;
#pragma unroll
                for (int ks = 0; ks < 8; ++ks) { const s16x4 lo = *(const LAS s16x4*)(vr + 32 * ks), hi = *(const LAS s16x4*)(vr + 32 * ks + 16);
                    o = MFMA16(__builtin_shufflevector(lo, hi, 0, 1, 2, 3, 4, 5, 6, 7), yp[rt][ks], o); }
                o = o * inv[rt];
                *(v2u*)(ATT + trow * 1024 + h * 256 + 16 * hh + 4 * g) = (v2u){pg8::cvt_pk_bf16(o[0], o[1]), pg8::cvt_pk_bf16(o[2], o[3])}; }
        }
        __syncthreads();
    }
}

#ifndef MK_N_LAUNCHES
#define MK_N_LAUNCHES 1
#endif
constexpr int NPHASES = 12;
__global__ void __launch_bounds__(NWAVES * 64, 2) fwd_kernel(Args args) {
    extern __shared__ __attribute__((aligned(16))) unsigned char lds_raw[];
    LAS unsigned char* lds = (LAS unsigned char*)lds_raw;
    const int tid = threadIdx.x, G = gridDim.x, bid = blockIdx.x;
    unsigned char* ws = args.ws;
    volatile LAS unsigned* MISC = (volatile LAS unsigned*)(lds + MISC_OFF);
    for (int u = tid; u < (LDS_BYTES - MISC_OFF) / 4; u += NWAVES * 64) ((LAS unsigned*)(lds + MISC_OFF))[u] = 0u;
    __syncthreads();
    XcdBarrier bar; bar.bar = (unsigned*)(ws + WS_CTL) + CW_BAR; bar.x = 0; bar.st = nullptr;
    if (MK_N_LAUNCHES == 1) bar = xcd_barrier_post((unsigned*)(ws + WS_CTL) + CW_BAR, MISC + 8);
    const int lo = args.ph_lo, hi = args.ph_hi;
#ifndef PH_MASK
#define PH_MASK 0xfff
#endif
#define IN(k) (((PH_MASK >> (k)) & 1) && lo <= (k) && (k) < hi)
#ifndef PH_REP
#define PH_REP 0
#endif
#define PHASE(k) if (IN(k)) for (int rp_ = 0; rp_ <= ((PH_REP >> (k)) & 1); ++rp_)
    unsigned long long tp0 = 0, tp1 = 0;
#define TP0(k) do { if (PROBE_K == (k)) tp0 = __builtin_amdgcn_s_memrealtime(); } while (0)
#define TP1(k) do { if (PROBE_K == (k)) tp1 = __builtin_amdgcn_s_memrealtime(); } while (0)
#define SEAM(k) do { if (IN(k) && IN((k) + 1)) xcd_barrier(bar); } while (0)
    using namespace pg8;
    const bf16_t* XB = (const bf16_t*)(ws + WS_XB);
    TP0(0);
    PHASE(0) { phase_prologue(args, lds, G); SEAM(0); }
    TP1(0);
    TP0(1);
    PHASE(1) {
        { Gemm g{XB, (const bf16_t*)(ws + WS_WIN), 1024, 1024, 1024}; StaticOrder S; S.init(T, NINP, G, bid);
          typedef Epi<1, 0, 0, 0, 0, 1> E_t; E_t E{(void*)(ws + WS_U), NU, (const float*)(ws + WS_RSTD0), 1.f, nullptr, nullptr, (float*)(ws + WS_GATES)};
          gemm_phase<E_t, StaticOrder, true, true>(lds, g, S, E); }
        { Gemm g{(const bf16_t*)(ws + WS_MEMN), (const bf16_t*)(ws + WS_WK), 1024, 1024, 1024}; StaticOrder S; S.init(TMEM, 1024, G, bid);
          typedef Epi<0, 0, 0, 0, 0, 0> E_t; E_t E{(void*)(ws + WS_KB), 1024, nullptr, 1.f, nullptr, nullptr, nullptr};
          gemm_phase<E_t, StaticOrder, true, true>(lds, g, S, E); }
        { Gemm g{(const bf16_t*)(ws + WS_WV), (const bf16_t*)(ws + WS_MEMN), 1024, 1024, 1024}; StaticOrder S; S.init(1024, TMEM, G, bid);
          typedef Epi<0, 0, 0, 0, 0, 0> E_t; E_t E{(void*)(ws + WS_VT), 4096, nullptr, 1.f, nullptr, nullptr, nullptr};
          gemm_phase<E_t, StaticOrder, true, true>(lds, g, S, E); }
        SEAM(1);
    TP1(1);
    }
    TP0(2);
    PHASE(2) { phase_prep(args, lds, G); SEAM(2); }
    TP1(2);
    TP0(3);
    PHASE(3) { phase_chain(args, lds, G); SEAM(3); }
    TP1(3);
    TP0(4);
    PHASE(4) { phase_mixout(args, lds, G); SEAM(4); }
    TP1(4);
    TP0(5);
    PHASE(5) {
        Gemm g{(const bf16_t*)(ws + WS_HM), (const bf16_t*)(ws + WS_WOUT), 1024, 1024, 1024}; StaticOrder S; S.init(T, 1024, G, bid);
        typedef Epi<0, 0, 1, 0, 1, 0> E_t; E_t E{(void*)(ws + WS_X1), 1024, nullptr, 1.f, (const void*)args.in[I_X], (float*)(ws + WS_SSP1), nullptr};
        gemm_phase<E_t, StaticOrder, true, true>(lds, g, S, E); SEAM(5);
    TP1(5);
    }
    TP0(6);
    PHASE(6) {
        Gemm g{(const bf16_t*)(ws + WS_X1), (const bf16_t*)(ws + WS_WQ), 1024, 1024, 1024}; StaticOrder S; S.init(T, 1024, G, bid);
        typedef Epi<2, 0, 0, 0, 0, 0> E_t; E_t E{(void*)(ws + WS_HQ), 1024, (const float*)(ws + WS_SSP1), 0.0625f, nullptr, nullptr, nullptr};
        gemm_phase<E_t, StaticOrder, true, true>(lds, g, S, E); SEAM(6);
    TP1(6);
    }
    TP0(7);
    PHASE(7) { phase_attn((const bf16*)(ws + WS_HQ), (const bf16*)(ws + WS_KB), (const bf16*)(ws + WS_VT), (bf16*)(ws + WS_ATT), lds, G); SEAM(7); }
    TP1(7);
    TP0(8);
    PHASE(8) {
        Gemm g{(const bf16_t*)(ws + WS_ATT), (const bf16_t*)(ws + WS_WO), 1024, 1024, 1024}; StaticOrder S; S.init(T, 1024, G, bid);
        typedef Epi<0, 0, 2, 0, 1, 0> E_t; E_t E{(void*)(ws + WS_X2), 1024, nullptr, 1.f, (const void*)(ws + WS_X1), (float*)(ws + WS_SSP2), nullptr};
        gemm_phase<E_t, StaticOrder, true, true>(lds, g, S, E); SEAM(8);
    TP1(8);
    }
    TP0(9);
    PHASE(9) {
        Gemm g{(const bf16_t*)(ws + WS_X2), (const bf16_t*)(ws + WS_W1), 1024, 1024, 1024}; StaticOrder S; S.init(T, DFF, G, bid);
        typedef Epi<2, 1, 0, 0, 0, 0> E_t; E_t E{(void*)(ws + WS_HID), DFF, (const float*)(ws + WS_SSP2), 1.f, nullptr, nullptr, nullptr};
        gemm_phase<E_t, StaticOrder, true, true>(lds, g, S, E); SEAM(9);
    TP1(9);
    }
    TP0(10);
    PHASE(10) {
        Gemm g{(const bf16_t*)(ws + WS_HID), (const bf16_t*)(ws + WS_W2), DFF, DFF, DFF}; StaticOrder S; S.init(T, 1024, G, bid);
        typedef Epi<0, 0, 2, 1, 1, 0> E_t; E_t E{(void*)args.out, 1024, nullptr, 1.f, (const void*)(ws + WS_X2), (float*)(ws + WS_SSP3), nullptr};
        gemm_phase<E_t, StaticOrder, true, true>(lds, g, S, E); SEAM(10);
    TP1(10);
    }
    TP0(11);
    if (IN(11)) phase_final(args.out, (const float*)(ws + WS_SSP3), args.in[I_FING], G);
    TP1(11);
    if (PROBE_K >= 0 && blockIdx.x == 0 && tid == 0) { const unsigned long long d8 = (PROBE_K >= 100 ? *(volatile LAS unsigned long long*)(lds + MISC_OFF + 128) : (tp1 - tp0)) * 8ull, t0 = __builtin_amdgcn_s_memrealtime(); while (__builtin_amdgcn_s_memrealtime() - t0 < d8) __builtin_amdgcn_s_sleep(8); }
#undef IN
#undef SEAM
}

extern "C" void kernel_launch(void* const* d_in, const int* in_sizes, int n_in, void* d_out, int out_size, void* d_ws, size_t ws_size, hipStream_t stream) {
    static int grid = 0;
    if (grid == 0) {
        if (n_in != 23 || in_sizes[0] != T * DM || out_size != T * DM || ws_size < WS_END) { fprintf(stderr, "kernel_launch: unexpected shapes (n_in %d, in0 %d, out %d, ws %zu); nothing launched\n", n_in, n_in > 0 ? in_sizes[0] : -1, out_size, ws_size); grid = -1; return; }
        int dev = 0, cus = 0;
        if (hipGetDevice(&dev) != hipSuccess || hipDeviceGetAttribute(&cus, hipDeviceAttributeMultiprocessorCount, dev) != hipSuccess) { grid = -1; return; }
        if (hipFuncSetAttribute((const void*)fwd_kernel, hipFuncAttributeMaxDynamicSharedMemorySize, LDS_BYTES) != hipSuccess) { fprintf(stderr, "kernel_launch: hipFuncSetAttribute failed\n"); grid = -1; return; }
        int per_cu = 0;
        if (hipOccupancyMaxActiveBlocksPerMultiprocessor(&per_cu, (const void*)fwd_kernel, NWAVES * 64, LDS_BYTES) != hipSuccess || per_cu < 1) fprintf(stderr, "kernel_launch: occupancy query reports %d\n", per_cu);
        (void)hipGetLastError();
        grid = cus;
    }
    if (grid < 0) return;
    (void)hipMemsetAsync((char*)d_ws + WS_CTL, 0, CTL_ZERO_BYTES, stream);
    Args a{};
    for (int i = 0; i < 23; ++i) a.in[i] = (const float*)d_in[i];
    a.out = (float*)d_out; a.ws = (unsigned char*)d_ws;
    if (MK_N_LAUNCHES == 1) { a.ph_lo = 0; a.ph_hi = NPHASES; hipLaunchKernelGGL(fwd_kernel, dim3(grid), dim3(NWAVES * 64), LDS_BYTES, stream, a); }
    else for (int p = 0; p < NPHASES; ++p) { a.ph_lo = p; a.ph_hi = p + 1; hipLaunchKernelGGL(fwd_kernel, dim3(grid), dim3(NWAVES * 64), LDS_BYTES, stream, a); }
}
```
